# Optimizing an MI355X kernel written in HIP

```python
import math
import jax, jax.numpy as jnp
from jax import lax
import numpy as np

D_MODEL = 1024
BATCH = 8
SEQ = 2048
DEPTH = 1

N_META = 16
BLOCK = 128
WINDOW = 128
PAD = (-N_META) % BLOCK
NORM_EPS = 1e-6

ATT_HEAD_DIM = 64
ATT_Q_HEADS = D_MODEL // ATT_HEAD_DIM
ATT_KV_HEADS = 4
ATT_GROUP = ATT_Q_HEADS // ATT_KV_HEADS
ATT_WIDTH = ATT_Q_HEADS * ATT_HEAD_DIM
KV_WIDTH = ATT_KV_HEADS * ATT_HEAD_DIM

SSM_INNER = 2 * D_MODEL
SSM_HEAD_DIM = 64
SSM_HEADS = SSM_INNER // SSM_HEAD_DIM
SSM_GROUPS = 4
SSM_HEADS_PER_GROUP = SSM_HEADS // SSM_GROUPS
SSM_STATE = 128
CONV_WIDTH = 4
CONV_DIM = SSM_INNER + 2 * SSM_GROUPS * SSM_STATE

SPLIT_SIZES = (ATT_WIDTH, KV_WIDTH, KV_WIDTH, ATT_WIDTH, SSM_INNER, CONV_DIM, SSM_HEADS, D_MODEL, D_MODEL)
SPLIT_POINTS = tuple(int(s) for s in np.cumsum(SPLIT_SIZES)[:-1])
IN_PROJ_DIM = int(sum(SPLIT_SIZES))

kernel_name = 'hybrid_swa_sink_alibi_ssd_gated_merge'


def rmsnorm(x, g):
    xf = x.astype(jnp.float32)
    y = xf * lax.rsqrt(jnp.mean(xf * xf, axis=-1, keepdims=True) + NORM_EPS) * g.astype(jnp.float32)
    return y.astype(x.dtype)


def alibi_slopes():
    return jnp.asarray(np.array([2.0 ** (-8.0 * (h + 1) / ATT_Q_HEADS) for h in range(ATT_Q_HEADS)], np.float32))


def sliding_window_attention(q, k, v, sinks):
    b, lp, _ = q.shape
    nb = lp // BLOCK
    km = k[:, PAD:PAD + N_META].reshape(b, N_META, ATT_KV_HEADS, ATT_HEAD_DIM)
    vm = v[:, PAD:PAD + N_META].reshape(b, N_META, ATT_KV_HEADS, ATT_HEAD_DIM)
    qb = q.reshape(b, nb, BLOCK, ATT_KV_HEADS, ATT_GROUP, ATT_HEAD_DIM) * (ATT_HEAD_DIM ** -0.5)

    def with_prev(t):
        t = t.reshape(b, nb, BLOCK, ATT_KV_HEADS, ATT_HEAD_DIM)
        prev = jnp.concatenate([jnp.zeros_like(t[:, :1]), t[:, :-1]], axis=1)
        return jnp.concatenate([prev, t], axis=2)

    kb, vb = with_prev(k), with_prev(v)

    q_pos = jnp.arange(nb)[:, None] * BLOCK + jnp.arange(BLOCK)[None, :]
    k_pos = jnp.arange(nb)[:, None] * BLOCK - BLOCK + jnp.arange(2 * BLOCK)[None, :]
    rel = q_pos[:, :, None] - k_pos[:, None, :]
    band_ok = (rel >= 0) & (rel < WINDOW) & (k_pos[:, None, :] >= PAD + N_META)
    meta_pos = PAD + jnp.arange(N_META)
    meta_ok = meta_pos[None, None, :] <= q_pos[:, :, None]

    slopes = alibi_slopes().reshape(1, 1, ATT_KV_HEADS, ATT_GROUP, 1, 1)
    s_band = jnp.einsum('bnqkgd,bnskd->bnkgqs', qb, kb).astype(jnp.float32)
    s_band = s_band - slopes * rel[None, :, None, None].astype(jnp.float32)
    s_band = jnp.where(band_ok[None, :, None, None], s_band, -jnp.inf)
    s_meta = jnp.einsum('bnqkgd,bmkd->bnkgqm', qb, km).astype(jnp.float32)
    s_meta = jnp.where(meta_ok[None, :, None, None], s_meta, -jnp.inf)
    sink = jnp.broadcast_to(sinks.astype(jnp.float32).reshape(1, 1, ATT_KV_HEADS, ATT_GROUP, 1, 1),
                            s_meta.shape[:-1] + (1,))
    p = jax.nn.softmax(jnp.concatenate([sink, s_meta, s_band], axis=-1), axis=-1).astype(v.dtype)
    p_meta, p_band = p[..., 1:1 + N_META], p[..., 1 + N_META:]
    o = jnp.einsum('bnkgqm,bmkd->bnqkgd', p_meta, vm) + jnp.einsum('bnkgqs,bnskd->bnqkgd', p_band, vb)
    return o.reshape(b, lp, ATT_WIDTH)


def causal_depthwise_conv(u, w, bias):
    out = lax.conv_general_dilated(u, w[:, None, :].astype(u.dtype), window_strides=(1,),
                                   padding=[(CONV_WIDTH - 1, 0)],
                                   dimension_numbers=('NWC', 'WIO', 'NWC'),
                                   feature_group_count=u.shape[-1])
    return out + bias.astype(u.dtype)


def segsum(a):
    T = a.shape[-1]
    cs = jnp.cumsum(a, axis=-1)
    diff = cs[..., :, None] - cs[..., None, :]
    return jnp.where(jnp.tril(jnp.ones((T, T), bool)), diff, -jnp.inf)


def ssd_chunked(x, dt, A, Bm, Cm):
    b, L = x.shape[:2]
    nc = L // BLOCK
    G, R, P, N = SSM_GROUPS, SSM_HEADS_PER_GROUP, SSM_HEAD_DIM, SSM_STATE
    xr = (x * dt[..., None]).reshape(b, nc, BLOCK, G, R, P)
    a = (dt * A).reshape(b, nc, BLOCK, G, R).transpose(0, 1, 3, 4, 2)
    Br = Bm.reshape(b, nc, BLOCK, G, N)
    Cr = Cm.reshape(b, nc, BLOCK, G, N)
    a_cs = jnp.cumsum(a, axis=-1)
    decay = jnp.exp(segsum(a))
    cb = jnp.einsum('bclgn,bcsgn->bcgls', Cr, Br)
    y_diag = jnp.einsum('bcgls,bcgrls,bcsgrp->bclgrp', cb, decay, xr)
    decay_states = jnp.exp(a_cs[..., -1:] - a_cs)
    states = jnp.einsum('bclgn,bcgrl,bclgrp->bcgrpn', Br, decay_states, xr)
    chunk_decay = jnp.exp(a_cs[..., -1])

    def step(carry, inp):
        s_c, d_c = inp
        return carry * d_c[..., None, None] + s_c, carry

    init = jnp.zeros((b, G, R, P, N), jnp.float32)
    _, prev = lax.scan(step, init, (jnp.moveaxis(states, 1, 0), jnp.moveaxis(chunk_decay, 1, 0)))
    prev = jnp.moveaxis(prev, 0, 1)
    y_off = jnp.einsum('bclgn,bcgrpn,bcgrl->bclgrp', Cr, prev, jnp.exp(a_cs))
    return (y_diag + y_off).reshape(b, L, SSM_HEADS, P)


def ssd_branch(z, xbc, dt_raw, conv_w, conv_b, dt_bias, a_log, d_skip, g_norm, valid):
    b, L, _ = xbc.shape
    xbc = jax.nn.silu(causal_depthwise_conv(xbc, conv_w, conv_b)) * valid[None, :, None]
    xbc = xbc.astype(jnp.float32)
    xs = xbc[..., :SSM_INNER].reshape(b, L, SSM_HEADS, SSM_HEAD_DIM)
    Bm = xbc[..., SSM_INNER:SSM_INNER + SSM_GROUPS * SSM_STATE].reshape(b, L, SSM_GROUPS, SSM_STATE)
    Cm = xbc[..., SSM_INNER + SSM_GROUPS * SSM_STATE:].reshape(b, L, SSM_GROUPS, SSM_STATE)
    dt = jax.nn.softplus(dt_raw.astype(jnp.float32) + dt_bias.astype(jnp.float32))
    A = -jnp.exp(a_log.astype(jnp.float32))
    y = ssd_chunked(xs, dt, A, Bm, Cm) + d_skip.astype(jnp.float32)[:, None] * xs
    y = y.reshape(b, L, SSM_INNER) * jax.nn.silu(z.astype(jnp.float32))
    yg = y.reshape(b, L, SSM_GROUPS, SSM_INNER // SSM_GROUPS)
    yg = yg * lax.rsqrt(jnp.mean(yg * yg, axis=-1, keepdims=True) + NORM_EPS)
    y = yg.reshape(b, L, SSM_INNER) * g_norm.astype(jnp.float32)
    return y.astype(z.dtype)


def hybrid_layer(h, valid, g_pre, w_in, conv_w, conv_b, dt_bias, a_log, d_skip, attn_sinks,
                 g_ssm_norm, w_out_att, w_out_ssm, w_out, g_post):
    u = rmsnorm(h, g_pre)
    proj = u @ w_in
    q, k, v, z_att, z_ssm, xbc, dt_raw, gate_att, gate_ssm = jnp.split(proj, SPLIT_POINTS, axis=-1)
    y_att = (sliding_window_attention(q, k, v, attn_sinks) * jax.nn.silu(z_att)) @ w_out_att
    y_ssm = ssd_branch(z_ssm, xbc, dt_raw, conv_w, conv_b, dt_bias, a_log, d_skip, g_ssm_norm, valid) @ w_out_ssm
    merged = jax.nn.sigmoid(gate_att) * y_att + jax.nn.sigmoid(gate_ssm) * y_ssm
    out = merged @ w_out
    return h + rmsnorm(out, g_post) * valid[None, :, None]


def setup_inputs(seed: int = 0) -> dict:
    key = jax.random.key(seed)
    ks = jax.random.split(key, 16)
    f32 = jnp.float32

    def nrm(k, shape, scale):
        return jax.random.normal(k, shape, f32) * scale

    x = nrm(ks[0], (BATCH, SEQ, D_MODEL), 1.0)
    meta_tokens = nrm(ks[1], (N_META, D_MODEL), 1.0)
    g_pre = 1.0 + nrm(ks[2], (DEPTH, D_MODEL), 0.01)
    w_in = nrm(ks[3], (DEPTH, D_MODEL, IN_PROJ_DIM), D_MODEL ** -0.5)
    conv_w = nrm(ks[4], (DEPTH, CONV_WIDTH, CONV_DIM), CONV_WIDTH ** -0.5)
    conv_b = nrm(ks[5], (DEPTH, CONV_DIM), 0.02)
    dt0 = jnp.exp(jax.random.uniform(ks[6], (DEPTH, SSM_HEADS), f32, math.log(1e-3), math.log(1e-1)))
    dt_bias = dt0 + jnp.log(-jnp.expm1(-dt0))
    a_log = jnp.log(jax.random.uniform(ks[7], (DEPTH, SSM_HEADS), f32, 1.0, 16.0))
    d_skip = 1.0 + nrm(ks[8], (DEPTH, SSM_HEADS), 0.1)
    attn_sinks = nrm(ks[9], (DEPTH, ATT_Q_HEADS), 0.5)
    g_ssm_norm = 1.0 + nrm(ks[10], (DEPTH, SSM_INNER), 0.01)
    w_out_att = nrm(ks[11], (DEPTH, ATT_WIDTH, D_MODEL), ATT_WIDTH ** -0.5)
    w_out_ssm = nrm(ks[12], (DEPTH, SSM_INNER, D_MODEL), SSM_INNER ** -0.5)
    w_out = nrm(ks[13], (DEPTH, D_MODEL, D_MODEL), D_MODEL ** -0.5)
    g_post = 1.0 + nrm(ks[14], (DEPTH, D_MODEL), 0.01)
    return {'x': x, 'meta_tokens': meta_tokens, 'g_pre': g_pre, 'w_in': w_in, 'conv_w': conv_w,
            'conv_b': conv_b, 'dt_bias': dt_bias, 'a_log': a_log, 'd_skip': d_skip,
            'attn_sinks': attn_sinks, 'g_ssm_norm': g_ssm_norm, 'w_out_att': w_out_att,
            'w_out_ssm': w_out_ssm, 'w_out': w_out, 'g_post': g_post}


def reference(x, meta_tokens, g_pre, w_in, conv_w, conv_b, dt_bias, a_log, d_skip, attn_sinks,
              g_ssm_norm, w_out_att, w_out_ssm, w_out, g_post):
    b = x.shape[0]
    lp = PAD + N_META + x.shape[1]
    h = jnp.concatenate([jnp.zeros((b, PAD, D_MODEL), x.dtype),
                         jnp.broadcast_to(meta_tokens.astype(x.dtype)[None], (b, N_META, D_MODEL)),
                         x], axis=1)
    valid = (jnp.arange(lp) >= PAD).astype(x.dtype)
    for i in range(DEPTH):
        h = hybrid_layer(h, valid, g_pre[i], w_in[i], conv_w[i], conv_b[i], dt_bias[i], a_log[i],
                         d_skip[i], attn_sinks[i], g_ssm_norm[i], w_out_att[i], w_out_ssm[i],
                         w_out[i], g_post[i])
    return h[:, PAD + N_META:]
```

```cpp
#include <hip/hip_runtime.h>
#include <hip/hip_cooperative_groups.h>
#include <cstdio>
namespace cg = cooperative_groups;

namespace pg8 {
#define PG8_LAS __attribute__((address_space(3)))
typedef unsigned short bf16_t;
typedef short bf16x8 __attribute__((ext_vector_type(8)));
typedef float f32x4 __attribute__((ext_vector_type(4)));
typedef unsigned u32x4 __attribute__((ext_vector_type(4)));
constexpr int BM = 256, BK = 64, HALF = 128, HTB = HALF * BK * 2  , STAGE_BYTES = 8 * HTB, NXCD = 8, WGM = 8;

__host__ __device__ __forceinline__ int lds_byte(int r, int c) { const int st = (r >> 4) * 2 + (c >> 5), rr = r & 15, cc = c & 31, ob = rr * 64 + cc * 2; return st * 1024 + (ob ^ (((ob >> 9) & 1) << 5)); }
__host__ __device__ __forceinline__ void stage_rc(int b, int& R, int& C) { const int st = b / 1024, sb = b % 1024, swz = sb ^ (((sb >> 9) & 1) << 5); R = (st >> 1) * 16 + swz / 64; C = (st & 1) * 32 + (swz % 64) / 2; }
__host__ __device__ __forceinline__ int perm32(int rho) { const int n = rho >> 4, i = rho & 15; return 8 * (i >> 2) + 4 * n + (i & 3); }

struct Unit { int pm, pn; };
struct Gemm { const bf16_t* A; const bf16_t* Bt; int M, N, K, lda, ldb; };

struct StaticOrder {
    int nM, nN, nwg, G, c;
    __host__ __device__ void init(int M, int N, int G_, int c_) { nM = M / BM; nN = N / BM; nwg = nM * nN; G = G_; c = c_; }
    __host__ __device__ bool next(int i, Unit& u) const {
        const long L = (long)i * G + c; if (L >= nwg) return false;
        int wgid = (int)L; { const int q = nwg / NXCD, r = nwg % NXCD, xcd = wgid % NXCD, off = wgid / NXCD; wgid = (xcd < r ? xcd * (q + 1) : r * (q + 1) + (xcd - r) * q) + off; }
        const int nig = WGM * nN, gid = wgid / nig, fm = gid * WGM, gsz = (nM - fm) < WGM ? (nM - fm) : WGM;
        u.pm = fm + ((wgid % nig) % gsz); u.pn = (wgid % nig) / gsz; return true;
    }
    __device__ __forceinline__ void a_ready(const Unit&) const {}
    __device__ __forceinline__ void done(const Unit&) const {}
};
template <class Epi, class Sched, bool STAMP = false>
__device__ __forceinline__ void gemm_phase(PG8_LAS unsigned char* lds, const Gemm g, const Sched& S, const Epi& E, unsigned long long* stamps) {
    const int tid = threadIdx.x, wid = __builtin_amdgcn_readfirstlane(tid >> 6), lane = tid & 63, wr = wid >> 2, wc = wid & 3, fr = lane & 15, fq = lane >> 4;
    const int K = g.K, nt = K / BK;
    int ts_lo = 0, ts_hi = 0, nts = 0; const unsigned long long rt_entry = STAMP ? (unsigned long long)wall_clock64() : 0ull;
#define PG8_STAMP() do { if (STAMP && wid == 0 && nts < 64) { const unsigned long long _c = (unsigned long long)clock64(); \
        ts_lo = (lane == nts) ? (int)(unsigned)_c : ts_lo; ts_hi = (lane == nts) ? (int)(unsigned)(_c >> 32) : ts_hi; ++nts; } } while (0)
    PG8_STAMP();
    unsigned voffA[2], voffB[2];
#pragma unroll
    for (int i = 0; i < 2; ++i) { int R, C; stage_rc(tid * 16 + i * 8192, R, C); const int Rb = Epi::PERM ? ((R & ~31) + perm32(R & 31)) : R;
        voffA[i] = (unsigned)(R * g.lda + C) * 2u; voffB[i] = (unsigned)(Rb * g.ldb + C) * 2u; }
    const size_t kstep = (size_t)(BK * 2);
    const size_t hstepA = (size_t)HALF * g.lda * 2, hstepB = (size_t)HALF * g.ldb * 2;
    const size_t tstepA = 2 * hstepA, tstepB = 2 * hstepB;
    const unsigned ldsw = (unsigned)wid * 1024u;
    const int aoff = lds_byte(wr * 64 + fr, fq * 8), boff = lds_byte(wc * 32 + fr, fq * 8);
#define PG8_SA(b, h) (((b) * 2 + (h)) * HTB)
#define PG8_SB(b, h) ((4 + (b) * 2 + (h)) * HTB)
#define PG8_STAGE(bufoff, gbase, voff) do { _Pragma("unroll") for (int _i = 0; _i < 2; ++_i) \
        __builtin_amdgcn_global_load_lds((const unsigned*)((const char*)(gbase) + (voff)[_i]), (PG8_LAS unsigned*)(lds + (bufoff) + ldsw + _i * 8192), 16, 0, 0); } while (0)
#define PG8_LDA(dst, b, h) do { _Pragma("unroll") for (int m = 0; m < 4; ++m) _Pragma("unroll") for (int k = 0; k < 2; ++k) dst[m][k] = *(const PG8_LAS bf16x8*)(lds + PG8_SA(b, h) + aoff + m * 2048 + k * 1024); } while (0)
#define PG8_LDB(dst, b, h) do { _Pragma("unroll") for (int n = 0; n < 2; ++n) _Pragma("unroll") for (int k = 0; k < 2; ++k) dst[n][k] = *(const PG8_LAS bf16x8*)(lds + PG8_SB(b, h) + boff + n * 2048 + k * 1024); } while (0)
#define PG8_MMA(ai, bj, At, Bt) do { __builtin_amdgcn_s_setprio(1); _Pragma("unroll") for (int m = 0; m < 4; ++m) _Pragma("unroll") for (int n = 0; n < 2; ++n) _Pragma("unroll") for (int k = 0; k < 2; ++k) \
        acc[ai][bj][m][n] = __builtin_amdgcn_mfma_f32_16x16x32_bf16(Bt[n][k], At[m][k], acc[ai][bj][m][n], 0, 0, 0); __builtin_amdgcn_s_setprio(0); } while (0)
#define PG8_WAIT_V(n) asm volatile("s_waitcnt vmcnt(" #n ")" ::: "memory")
#define PG8_WAIT_L(n) asm volatile("s_waitcnt lgkmcnt(" #n ")" ::: "memory")
#define PG8_BAR __builtin_amdgcn_s_barrier()
#define PG8_SCHED __builtin_amdgcn_sched_barrier(0)
    Unit cur, nxt; int ui = 0;
    if (!S.next(0, cur)) return;
    f32x4 acc[2][2][4][2];
#pragma unroll
    for (int a = 0; a < 2; ++a)
#pragma unroll
        for (int b = 0; b < 2; ++b)
#pragma unroll
            for (int m = 0; m < 4; ++m)
#pragma unroll
                for (int n = 0; n < 2; ++n) acc[a][b][m][n] = (f32x4){0.f, 0.f, 0.f, 0.f};
    bf16x8 At[4][2], B0[2][2], B1[2][2];
    const char* cA = (const char*)g.A + (size_t)cur.pm * tstepA; const char* cB = (const char*)g.Bt + (size_t)cur.pn * tstepB;
    S.a_ready(cur);
    PG8_STAGE(PG8_SB(0, 0), cB, voffB); PG8_STAGE(PG8_SA(0, 0), cA, voffA); PG8_STAGE(PG8_SB(0, 1), cB + hstepB, voffB); PG8_STAGE(PG8_SA(0, 1), cA + hstepA, voffA);
    if (wr == 1) PG8_BAR;
    PG8_WAIT_V(4); PG8_BAR;
    PG8_STAGE(PG8_SB(1, 0), cB + kstep, voffB); PG8_STAGE(PG8_SA(1, 0), cA + kstep, voffA); PG8_STAGE(PG8_SB(1, 1), cB + hstepB + kstep, voffB);
    PG8_WAIT_V(6); PG8_BAR;
    PG8_STAMP();
    for (;;) {
        const bool has_next = S.next(ui + 1, nxt);
        const char* nA = has_next ? (const char*)g.A + (size_t)nxt.pm * tstepA : cA; const char* nB = has_next ? (const char*)g.Bt + (size_t)nxt.pn * tstepB : cB;
        for (int t = 0; t < nt; t += 2) {
            const bool last = (t == nt - 2);
            const char* a1 = cA + (size_t)(t + 1) * kstep;
            const char* a2 = last ? nA : cA + (size_t)(t + 2) * kstep; const char* b2 = last ? nB : cB + (size_t)(t + 2) * kstep;
            const char* a3 = a2 + kstep; const char* b3 = b2 + kstep;
            if (last && has_next) S.a_ready(nxt);
            PG8_LDB(B0, 0, 0); PG8_SCHED; PG8_LDA(At, 0, 0); PG8_STAGE(PG8_SA(1, 1), a1 + hstepA, voffA);
            PG8_WAIT_L(8); PG8_BAR; PG8_WAIT_L(0); PG8_MMA(0, 0, At, B0); PG8_BAR; PG8_SCHED;
            PG8_LDB(B1, 0, 1); PG8_STAGE(PG8_SB(0, 0), b2, voffB);
            PG8_BAR; PG8_WAIT_L(0); PG8_MMA(0, 1, At, B1); PG8_BAR;
            PG8_LDA(At, 0, 1); PG8_STAGE(PG8_SA(0, 0), a2, voffA);
            PG8_BAR; PG8_WAIT_L(0); PG8_MMA(1, 0, At, B0); PG8_BAR; PG8_SCHED;
            PG8_STAGE(PG8_SB(0, 1), b2 + hstepB, voffB);
            PG8_WAIT_V(6); PG8_BAR; PG8_MMA(1, 1, At, B1); PG8_BAR;
            PG8_LDB(B0, 1, 0); PG8_SCHED; PG8_LDA(At, 1, 0); PG8_STAGE(PG8_SA(0, 1), a2 + hstepA, voffA);
            PG8_WAIT_L(8); PG8_BAR; PG8_WAIT_L(0); PG8_MMA(0, 0, At, B0); PG8_BAR; PG8_SCHED;
            PG8_LDB(B1, 1, 1); PG8_STAGE(PG8_SB(1, 0), b3, voffB);
            PG8_BAR; PG8_WAIT_L(0); PG8_MMA(0, 1, At, B1); PG8_BAR;
            PG8_LDA(At, 1, 1); PG8_STAGE(PG8_SA(1, 0), a3, voffA);
            PG8_BAR; PG8_WAIT_L(0); PG8_MMA(1, 0, At, B0); PG8_BAR; PG8_SCHED;
            PG8_STAGE(PG8_SB(1, 1), b3 + hstepB, voffB);
            PG8_WAIT_V(6); PG8_BAR; PG8_MMA(1, 1, At, B1); PG8_BAR;
        }
        PG8_STAMP();
        if constexpr (!Epi::AFTER_DRAIN) { E(acc, cur, wr, wc, fr, fq); S.done(cur); }
        PG8_STAMP();
        if (!has_next) break;
#pragma unroll
        for (int a = 0; a < 2; ++a)
#pragma unroll
            for (int b = 0; b < 2; ++b)
#pragma unroll
                for (int m = 0; m < 4; ++m)
#pragma unroll
                    for (int n = 0; n < 2; ++n) acc[a][b][m][n] = (f32x4){0.f, 0.f, 0.f, 0.f};
        cur = nxt; cA = nA; cB = nB; ++ui;
    }
    PG8_WAIT_V(0);
    if (wr == 0) PG8_BAR;
    PG8_BAR;
    if constexpr (Epi::AFTER_DRAIN) { E.fused(acc, cur, wr, wc, fr, fq, lds, wid, lane); S.done(cur); }
    PG8_STAMP();
    if (STAMP && wid == 0) { stamps[lane] = lane < nts ? (((unsigned long long)(unsigned)ts_hi << 32) | (unsigned)ts_lo) : 0ull;
        if (lane == 62) stamps[62] = rt_entry; if (lane == 63) stamps[63] = (unsigned long long)wall_clock64(); }
#undef PG8_STAMP
#undef PG8_SA
#undef PG8_SB
#undef PG8_STAGE
#undef PG8_LDA
#undef PG8_LDB
#undef PG8_MMA
#undef PG8_WAIT_V
#undef PG8_WAIT_L
#undef PG8_BAR
#undef PG8_SCHED
}
}

namespace mk {
using pg8::bf16_t; using pg8::bf16x8; using pg8::f32x4; using pg8::u32x4;
#define LAS __attribute__((address_space(3)))
typedef unsigned u32x2 __attribute__((ext_vector_type(2)));

constexpr int DM = 1024, NBATCH = 8, TSEQ = 2048, NROW = NBATCH * TSEQ;
constexpr int NIN = 9760;
constexpr int LDA_A = 3584;
constexpr int NATT = 3840;
constexpr int LDB_S = 6144;
constexpr float EPS = 1e-6f;
constexpr int LDS_BYTES = 144 * 1024;

constexpr size_t WS_WT_ATT = 0;
constexpr size_t WS_WT_SSM = WS_WT_ATT + (size_t)NATT * DM * 2;
constexpr size_t WS_WOA    = WS_WT_SSM + (size_t)LDB_S * DM * 2;
constexpr size_t WS_WOS    = WS_WOA + (size_t)DM * DM * 2;
constexpr size_t WS_WO     = WS_WOS + (size_t)DM * 2048 * 2;
constexpr size_t WS_U      = WS_WO + (size_t)DM * DM * 2;
constexpr size_t WS_DT     = WS_U + (size_t)NROW * DM * 2;
constexpr size_t WS_SSQ    = WS_DT + (size_t)NROW * 32 * 4;
constexpr size_t WS_MKV    = WS_SSQ + (size_t)NROW * 32 * 4;
constexpr size_t WS_MXBC   = WS_MKV + 16 * 512 * 2;
constexpr size_t WS_MDT    = WS_MXBC + 16 * 3072 * 2;
constexpr size_t WS_BUF    = WS_MDT + 16 * 32 * 4;
constexpr size_t WS_END    = WS_BUF + (size_t)NROW * LDB_S * 2;

struct Params {
    const float *x, *meta, *g_pre, *w_in, *conv_w, *conv_b, *dt_bias, *a_log, *d_skip, *sinks, *g_ssm, *w_oa, *w_os, *w_o, *g_post;
    float* out; unsigned char* ws; int ph_lo, ph_hi;
};

typedef __bf16 bf16v2 __attribute__((ext_vector_type(2)));
typedef float f32v2 __attribute__((ext_vector_type(2)));
__device__ __forceinline__ unsigned pk2(float lo, float hi) { const f32v2 v = {lo, hi}; const bf16v2 b = __builtin_convertvector(v, bf16v2); return __builtin_bit_cast(unsigned, b); }
__device__ __forceinline__ float lo_f(unsigned w) { return __uint_as_float(w << 16); }
__device__ __forceinline__ float hi_f(unsigned w) { return __uint_as_float(w & 0xffff0000u); }
__device__ __forceinline__ float sigm(float x) { return 1.f / (1.f + __expf(-x)); }
__device__ __forceinline__ float silu(float x) { return x / (1.f + __expf(-x)); }
__device__ __forceinline__ float softplus(float x) { return fmaxf(x, 0.f) + log1pf(__expf(-fabsf(x))); }
__device__ __forceinline__ float wave_sum(float v) {
#pragma unroll
    for (int o = 1; o < 64; o <<= 1) v += __shfl_xor(v, o);
    return v;
}
__device__ __forceinline__ bf16x8 as_bf16x8(u32x4 v) { union { u32x4 u; bf16x8 b; } c; c.u = v; return c.b; }

struct EpiStore {
    static constexpr bool PERM = true, AFTER_DRAIN = false;
    bf16_t* O; int ldc;
    __device__ __forceinline__ void operator()(const f32x4 (&acc)[2][2][4][2], const pg8::Unit& u, int wr, int wc, int fr, int fq) const {
        const int row0 = u.pm * 256 + wr * 64 + fr, col0 = u.pn * 256 + wc * 32 + 8 * fq;
#pragma unroll
        for (int ai = 0; ai < 2; ++ai)
#pragma unroll
            for (int m = 0; m < 4; ++m) { bf16_t* rowp = O + (size_t)(row0 + ai * 128 + m * 16) * ldc + col0;
#pragma unroll
                for (int bj = 0; bj < 2; ++bj) { const f32x4 v0 = acc[ai][bj][m][0], v1 = acc[ai][bj][m][1];
                    u32x4 w; w.x = pk2(v0[0], v0[1]); w.y = pk2(v0[2], v0[3]); w.z = pk2(v1[0], v1[1]); w.w = pk2(v1[2], v1[3]);
                    *(u32x4*)(rowp + bj * 128) = w; } }
    }
};
struct EpiAtt {
    static constexpr bool PERM = true, AFTER_DRAIN = false;
    bf16_t* O; float* dt; const float* dt_bias;
    __device__ __forceinline__ void operator()(const f32x4 (&acc)[2][2][4][2], const pg8::Unit& u, int wr, int wc, int fr, int fq) const {
        const int row0 = u.pm * 256 + wr * 64 + fr;
        if (u.pn < 14) { EpiStore e{O, LDA_A}; e(acc, u, wr, wc, fr, fq); }
        else if (wc == 0) {
#pragma unroll
            for (int n = 0; n < 2; ++n) { const int col = 8 * fq + 4 * n; const f32x4 bv = *(const f32x4*)(dt_bias + col);
#pragma unroll
                for (int ai = 0; ai < 2; ++ai)
#pragma unroll
                    for (int m = 0; m < 4; ++m) { const f32x4 v = acc[ai][0][m][n] + bv; f32x4 o; o[0] = softplus(v[0]); o[1] = softplus(v[1]); o[2] = softplus(v[2]); o[3] = softplus(v[3]);
                        *(f32x4*)(dt + (size_t)(row0 + ai * 128 + m * 16) * 32 + col) = o; } }
        }
    }
};
struct EpiYatt {
    static constexpr bool PERM = true, AFTER_DRAIN = false;
    const bf16_t* bufA; bf16_t* m1;
    __device__ __forceinline__ void operator()(const f32x4 (&acc)[2][2][4][2], const pg8::Unit& u, int wr, int wc, int fr, int fq) const {
        const int row0 = u.pm * 256 + wr * 64 + fr, col0 = u.pn * 256 + wc * 32 + 8 * fq;
#pragma unroll
        for (int ai = 0; ai < 2; ++ai)
#pragma unroll
            for (int m = 0; m < 4; ++m) { const size_t row = (size_t)(row0 + ai * 128 + m * 16);
#pragma unroll
                for (int bj = 0; bj < 2; ++bj) { const int col = col0 + bj * 128; const f32x4 v0 = acc[ai][bj][m][0], v1 = acc[ai][bj][m][1];
                    const u32x4 gt = *(const u32x4*)(bufA + row * LDA_A + 2560 + col);
                    u32x4 w; w.x = pk2(v0[0] * sigm(lo_f(gt.x)), v0[1] * sigm(hi_f(gt.x))); w.y = pk2(v0[2] * sigm(lo_f(gt.y)), v0[3] * sigm(hi_f(gt.y)));
                    w.z = pk2(v1[0] * sigm(lo_f(gt.z)), v1[1] * sigm(hi_f(gt.z))); w.w = pk2(v1[2] * sigm(lo_f(gt.w)), v1[3] * sigm(hi_f(gt.w)));
                    *(u32x4*)(m1 + row * DM + col) = w; } }
    }
};
struct EpiYssm {
    static constexpr bool PERM = true, AFTER_DRAIN = false;
    const bf16_t* bufB; const bf16_t* m1; bf16_t* mg;
    __device__ __forceinline__ void operator()(const f32x4 (&acc)[2][2][4][2], const pg8::Unit& u, int wr, int wc, int fr, int fq) const {
        const int row0 = u.pm * 256 + wr * 64 + fr, col0 = u.pn * 256 + wc * 32 + 8 * fq;
#pragma unroll
        for (int ai = 0; ai < 2; ++ai)
#pragma unroll
            for (int m = 0; m < 4; ++m) { const size_t row = (size_t)(row0 + ai * 128 + m * 16);
#pragma unroll
                for (int bj = 0; bj < 2; ++bj) { const int col = col0 + bj * 128; const f32x4 v0 = acc[ai][bj][m][0], v1 = acc[ai][bj][m][1];
                    const u32x4 gt = *(const u32x4*)(bufB + row * LDB_S + 5120 + col); const u32x4 mm = *(const u32x4*)(m1 + row * DM + col);
                    u32x4 w; w.x = pk2(lo_f(mm.x) + v0[0] * sigm(lo_f(gt.x)), hi_f(mm.x) + v0[1] * sigm(hi_f(gt.x))); w.y = pk2(lo_f(mm.y) + v0[2] * sigm(lo_f(gt.y)), hi_f(mm.y) + v0[3] * sigm(hi_f(gt.y)));
                    w.z = pk2(lo_f(mm.z) + v1[0] * sigm(lo_f(gt.z)), hi_f(mm.z) + v1[1] * sigm(hi_f(gt.z))); w.w = pk2(lo_f(mm.w) + v1[2] * sigm(lo_f(gt.w)), hi_f(mm.w) + v1[3] * sigm(hi_f(gt.w)));
                    *(u32x4*)(mg + row * DM + col) = w; } }
    }
};
struct EpiF32 {
    static constexpr bool PERM = false, AFTER_DRAIN = false;
    float* C; int ldc;
    __device__ __forceinline__ void operator()(const f32x4 (&acc)[2][2][4][2], const pg8::Unit& u, int wr, int wc, int fr, int fq) const {
        const int row0 = u.pm * 256 + wr * 64 + fr, col0 = u.pn * 256 + wc * 32 + 4 * fq;
#pragma unroll
        for (int ai = 0; ai < 2; ++ai)
#pragma unroll
            for (int m = 0; m < 4; ++m) { float* rowp = C + (size_t)(row0 + ai * 128 + m * 16) * ldc + col0;
#pragma unroll
                for (int bj = 0; bj < 2; ++bj)
#pragma unroll
                    for (int n = 0; n < 2; ++n) *(f32x4*)(rowp + bj * 128 + n * 16) = acc[ai][bj][m][n]; }
    }
};

__device__ __forceinline__ void prep_phase(const Params& p, LAS unsigned char* lds) {
    const int tid = threadIdx.x, lane = tid & 63, wave = __builtin_amdgcn_readfirstlane(tid >> 6), G = gridDim.x;
    unsigned char* ws = p.ws;
    for (int ci = blockIdx.x; ci < 226; ci += G) {
        LAS float* um = (LAS float*)lds;
        LAS float* Wl = (LAS float*)(lds + 65536);
        LAS float* red = (LAS float*)(lds + 131072);
        const int c0 = ci < 32 ? 1024 + 16 * ci : (ci < 224 ? 4608 + 16 * (ci - 32) : 7680 + 16 * (ci - 224));
        __syncthreads();
#pragma unroll
        for (int rr = 0; rr < 2; ++rr) { const int r = 2 * wave + rr; f32x4 v[4]; float s = 0.f;
#pragma unroll
            for (int i = 0; i < 4; ++i) { v[i] = *(const f32x4*)(p.meta + r * DM + 4 * lane + 256 * i); s += v[i][0] * v[i][0] + v[i][1] * v[i][1] + v[i][2] * v[i][2] + v[i][3] * v[i][3]; }
            const float rstd = rsqrtf(wave_sum(s) * (1.f / DM) + EPS);
#pragma unroll
            for (int i = 0; i < 4; ++i) { const f32x4 gg = *(const f32x4*)(p.g_pre + 4 * lane + 256 * i); *(LAS f32x4*)(um + r * DM + 4 * lane + 256 * i) = v[i] * rstd * gg; } }
#pragma unroll
        for (int i = 0; i < 8; ++i) { const int idx = tid + 512 * i, k = idx >> 2, c4 = idx & 3; *(LAS f32x4*)(Wl + k * 16 + 4 * c4) = *(const f32x4*)(p.w_in + (size_t)k * NIN + c0 + 4 * c4); }
        __syncthreads();
        { const int c = tid & 15, r = (tid >> 4) & 15, kh = tid >> 8; float s = 0.f;
          for (int k = 512 * kh; k < 512 * kh + 512; k += 4) { const f32x4 uu = *(const LAS f32x4*)(um + r * DM + k);
              s += uu[0] * Wl[(k + 0) * 16 + c] + uu[1] * Wl[(k + 1) * 16 + c] + uu[2] * Wl[(k + 2) * 16 + c] + uu[3] * Wl[(k + 3) * 16 + c]; }
          red[kh * 256 + (tid & 255)] = s; }
        __syncthreads();
        if (tid < 256) { const float s = red[tid] + red[256 + tid]; const int c = tid & 15, r = tid >> 4;
            if (ci < 32) ((bf16_t*)(ws + WS_MKV))[r * 512 + 16 * ci + c] = (bf16_t)(pk2(s, 0.f) & 0xffffu);
            else if (ci < 224) ((bf16_t*)(ws + WS_MXBC))[r * 3072 + 16 * (ci - 32) + c] = (bf16_t)(pk2(s, 0.f) & 0xffffu);
            else { const int j = 16 * (ci - 224) + c; ((float*)(ws + WS_MDT))[r * 32 + j] = softplus(s + p.dt_bias[j]); } }
        __syncthreads();
    }
    {   LAS float* tile = (LAS float*)lds;
        constexpr int T_ATT = (NATT / 64) * 16, T_SSM = (LDB_S / 64) * 16, T_OA = 256, T_OS = 512, T_O = 256, T_ALL = T_ATT + T_SSM + T_OA + T_OS + T_O;
        for (int it = blockIdx.x; it < T_ALL; it += G) {
            const float* src; int ld, K, n0, k0, scol = 0, nvalid = 64; bf16_t* dst; const float* kscale = nullptr; int r = it;
            if (r < T_ATT) { src = p.w_in; ld = NIN; K = DM; n0 = 64 * (r >> 4); k0 = 64 * (r & 15); dst = (bf16_t*)(ws + WS_WT_ATT);
                if (n0 < 2560) scol = n0; else if (n0 < 3584) scol = 7712 + (n0 - 2560); else if (n0 == 3584) { scol = 7680; nvalid = 32; } else nvalid = 0; }
            else if ((r -= T_ATT) < T_SSM) { src = p.w_in; ld = NIN; K = DM; n0 = 64 * (r >> 4); k0 = 64 * (r & 15); dst = (bf16_t*)(ws + WS_WT_SSM);
                if (n0 < 2048) scol = 2560 + n0; else if (n0 < 5120) scol = 4608 + (n0 - 2048); else scol = 8736 + (n0 - 5120); }
            else if ((r -= T_SSM) < T_OA) { src = p.w_oa; ld = DM; K = DM; n0 = 64 * (r >> 4); k0 = 64 * (r & 15); dst = (bf16_t*)(ws + WS_WOA); scol = n0; }
            else if ((r -= T_OA) < T_OS) { src = p.w_os; ld = DM; K = 2048; n0 = 64 * (r >> 5); k0 = 64 * (r & 31); dst = (bf16_t*)(ws + WS_WOS); scol = n0; kscale = p.g_ssm; }
            else { r -= T_OS; src = p.w_o; ld = DM; K = DM; n0 = 64 * (r >> 4); k0 = 64 * (r & 15); dst = (bf16_t*)(ws + WS_WO); scol = n0; }
            const int kk = tid >> 4, c4 = tid & 15;
#pragma unroll
            for (int rep = 0; rep < 2; ++rep) { const int k = kk + 32 * rep; f32x4 v = {0.f, 0.f, 0.f, 0.f};
                if (4 * c4 < nvalid) v = *(const f32x4*)(src + (size_t)(k0 + k) * ld + scol + 4 * c4);
                if (kscale) v = v * kscale[k0 + k];
                tile[k * 65 + 4 * c4 + 0] = v[0]; tile[k * 65 + 4 * c4 + 1] = v[1]; tile[k * 65 + 4 * c4 + 2] = v[2]; tile[k * 65 + 4 * c4 + 3] = v[3]; }
            __syncthreads();
            { const int n = tid >> 3, k8 = tid & 7; const LAS float* s = tile + (8 * k8) * 65 + n;
              u32x4 o; o.x = pk2(s[0], s[65]); o.y = pk2(s[2 * 65], s[3 * 65]); o.z = pk2(s[4 * 65], s[5 * 65]); o.w = pk2(s[6 * 65], s[7 * 65]);
              *(u32x4*)(dst + (size_t)(n0 + n) * K + k0 + 8 * k8) = o; }
            __syncthreads();
        }
    }
    {   bf16_t* U = (bf16_t*)(ws + WS_U);
        for (int row = blockIdx.x * 8 + wave; row < NROW; row += G * 8) { f32x4 v[4]; float s = 0.f;
#pragma unroll
            for (int i = 0; i < 4; ++i) { v[i] = *(const f32x4*)(p.x + (size_t)row * DM + 4 * lane + 256 * i); s += v[i][0] * v[i][0] + v[i][1] * v[i][1] + v[i][2] * v[i][2] + v[i][3] * v[i][3]; }
            const float rstd = rsqrtf(wave_sum(s) * (1.f / DM) + EPS);
#pragma unroll
            for (int i = 0; i < 4; ++i) { const f32x4 gg = *(const f32x4*)(p.g_pre + 4 * lane + 256 * i); const f32x4 o = v[i] * rstd * gg;
                u32x2 w; w.x = pk2(o[0], o[1]); w.y = pk2(o[2], o[3]); *(u32x2*)(U + (size_t)row * DM + 4 * lane + 256 * i) = w; } }
    }
}

__device__ __forceinline__ void attn_phase(const Params& p, LAS unsigned char* lds) {
    const int tid = threadIdx.x, lane = tid & 63, wave = __builtin_amdgcn_readfirstlane(tid >> 6), fr = lane & 15, fq = lane >> 4;
    constexpr int KP = 72, VP = 296;
    LAS bf16_t* Ks = (LAS bf16_t*)lds;
    LAS bf16_t* Vt = (LAS bf16_t*)(lds + 288 * KP * 2);
    bf16_t* bufA = (bf16_t*)(p.ws + WS_BUF); const bf16_t* mkv = (const bf16_t*)(p.ws + WS_MKV);
    for (int item = blockIdx.x; item < 512; item += gridDim.x) {
        const int g = item & 3, j = (item >> 2) & 15, b = item >> 6;
        __syncthreads();
        for (int idx = tid; idx < 288 * 8; idx += 512) { const int s = idx >> 3, oc = idx & 7; u32x4 kv = {0u, 0u, 0u, 0u}, vv = {0u, 0u, 0u, 0u};
            if (s < 16) { kv = *(const u32x4*)(mkv + s * 512 + 64 * g + 8 * oc); vv = *(const u32x4*)(mkv + s * 512 + 256 + 64 * g + 8 * oc); }
            else if (s >= 32) { const int tk = 128 * j - 160 + s;
                if (tk >= 0) { const bf16_t* rp = bufA + (size_t)(b * TSEQ + tk) * LDA_A + 64 * g + 8 * oc; kv = *(const u32x4*)(rp + 1024); vv = *(const u32x4*)(rp + 1280); } }
            *(LAS u32x4*)(Ks + s * KP + 8 * oc) = kv;
            LAS bf16_t* vp = Vt + (8 * oc) * VP + s;
            vp[0 * VP] = (bf16_t)(vv.x & 0xffffu); vp[1 * VP] = (bf16_t)(vv.x >> 16); vp[2 * VP] = (bf16_t)(vv.y & 0xffffu); vp[3 * VP] = (bf16_t)(vv.y >> 16);
            vp[4 * VP] = (bf16_t)(vv.z & 0xffffu); vp[5 * VP] = (bf16_t)(vv.z >> 16); vp[6 * VP] = (bf16_t)(vv.w & 0xffffu); vp[7 * VP] = (bf16_t)(vv.w >> 16); }
        __syncthreads();
        const int hq = wave >> 1, half = wave & 1, H = 4 * g + hq;
        const float slope = exp2f(-0.5f * (float)(H + 1)), sink = p.sinks[H];
#pragma unroll 1
        for (int qt = 0; qt < 4; ++qt) {
            const int tq = 128 * j + 64 * half + 16 * qt + fr;
            bf16_t* rowp = bufA + (size_t)(b * TSEQ + tq) * LDA_A;
            bf16x8 qf[2];
            qf[0] = *(const bf16x8*)(rowp + 64 * H + 8 * fq); qf[1] = *(const bf16x8*)(rowp + 64 * H + 32 + 8 * fq);
            f32x4 sa[18];
#pragma unroll
            for (int st = 0; st < 18; ++st) { f32x4 a = {0.f, 0.f, 0.f, 0.f};
                if (st != 1) {
#pragma unroll
                    for (int ks = 0; ks < 2; ++ks) { const bf16x8 kf = *(const LAS bf16x8*)(Ks + (16 * st + fr) * KP + 32 * ks + 8 * fq); a = __builtin_amdgcn_mfma_f32_16x16x32_bf16(kf, qf[ks], a, 0, 0, 0); } }
                sa[st] = a; if (st & 1) __builtin_amdgcn_sched_barrier(0); }
            float mx = sink;
#pragma unroll
            for (int st = 0; st < 18; ++st)
#pragma unroll
                for (int jj = 0; jj < 4; ++jj) { float lg;
                    if (st == 0) lg = sa[0][jj] * 0.125f;
                    else if (st == 1) lg = -INFINITY;
                    else { const int s = 16 * st + 4 * fq + jj, tk = 128 * j - 160 + s, rel = tq - tk; const bool ok = (rel >= 0) && (rel < 128) && (tk >= 0);
                        lg = ok ? sa[st][jj] * 0.125f - slope * (float)rel : -INFINITY; }
                    sa[st][jj] = lg; mx = fmaxf(mx, lg); }
            mx = fmaxf(mx, __shfl_xor(mx, 16)); mx = fmaxf(mx, __shfl_xor(mx, 32));
            float sum = 0.f;
#pragma unroll
            for (int st = 0; st < 18; ++st)
#pragma unroll
                for (int jj = 0; jj < 4; ++jj) { const float e = __expf(sa[st][jj] - mx); sa[st][jj] = e; sum += e; }
            sum += __shfl_xor(sum, 16); sum += __shfl_xor(sum, 32); sum += __expf(sink - mx);
            const float inv = 1.f / sum;
            f32x4 oa[4];
#pragma unroll
            for (int dt = 0; dt < 4; ++dt) oa[dt] = (f32x4){0.f, 0.f, 0.f, 0.f};
#pragma unroll
            for (int u = 0; u < 9; ++u) { u32x4 pw; pw.x = pk2(sa[2 * u][0], sa[2 * u][1]); pw.y = pk2(sa[2 * u][2], sa[2 * u][3]); pw.z = pk2(sa[2 * u + 1][0], sa[2 * u + 1][1]); pw.w = pk2(sa[2 * u + 1][2], sa[2 * u + 1][3]);
                const bf16x8 pf = as_bf16x8(pw);
#pragma unroll
                for (int dt = 0; dt < 4; ++dt) { const LAS bf16_t* vr = Vt + (16 * dt + fr) * VP + 32 * u + 4 * fq; const u32x2 v0 = *(const LAS u32x2*)vr, v1 = *(const LAS u32x2*)(vr + 16);
                    u32x4 vw; vw.x = v0.x; vw.y = v0.y; vw.z = v1.x; vw.w = v1.y;
                    oa[dt] = __builtin_amdgcn_mfma_f32_16x16x32_bf16(as_bf16x8(vw), pf, oa[dt], 0, 0, 0); }
                __builtin_amdgcn_sched_barrier(0); }
#pragma unroll
            for (int dt = 0; dt < 4; ++dt) { const int col = 64 * H + 16 * dt + 4 * fq; const u32x2 zz = *(const u32x2*)(rowp + 1536 + col);
                u32x2 w; w.x = pk2(oa[dt][0] * inv * silu(lo_f(zz.x)), oa[dt][1] * inv * silu(hi_f(zz.x))); w.y = pk2(oa[dt][2] * inv * silu(lo_f(zz.y)), oa[dt][3] * inv * silu(hi_f(zz.y)));
                *(u32x2*)(rowp + col) = w; }
        }
    }
}

__device__ __forceinline__ u32x4 xbc_row(const bf16_t* bufB, const bf16_t* mxbc, int b, int pos, int xc) {
    u32x4 z = {0u, 0u, 0u, 0u};
    if (pos < 0) return z;
#ifdef DBG_NOMETA
    if (pos < 16) return z;
#endif
    if (pos < 16) return *(const u32x4*)(mxbc + pos * 3072 + xc);
    return *(const u32x4*)(bufB + (size_t)(b * TSEQ + pos - 16) * LDB_S + 2048 + xc);
}
__device__ __forceinline__ void conv_block(const Params& p, const bf16_t* bufB, const bf16_t* mxbc, int b, int pos0, int xc, float (&out)[4][8]) {
    float w[4][8];
#pragma unroll
    for (int k = 0; k < 4; ++k) { const f32x4 a = *(const f32x4*)(p.conv_w + k * 3072 + xc), c = *(const f32x4*)(p.conv_w + k * 3072 + xc + 4);
        w[k][0] = a[0]; w[k][1] = a[1]; w[k][2] = a[2]; w[k][3] = a[3]; w[k][4] = c[0]; w[k][5] = c[1]; w[k][6] = c[2]; w[k][7] = c[3]; }
    { const f32x4 a = *(const f32x4*)(p.conv_b + xc), c = *(const f32x4*)(p.conv_b + xc + 4);
#pragma unroll
      for (int r = 0; r < 4; ++r) { out[r][0] = a[0]; out[r][1] = a[1]; out[r][2] = a[2]; out[r][3] = a[3]; out[r][4] = c[0]; out[r][5] = c[1]; out[r][6] = c[2]; out[r][7] = c[3]; } }
#pragma unroll
    for (int i = 0; i < 7; ++i) { const u32x4 rw = xbc_row(bufB, mxbc, b, pos0 - 3 + i, xc);
        float xv[8]; xv[0] = lo_f(rw.x); xv[1] = hi_f(rw.x); xv[2] = lo_f(rw.y); xv[3] = hi_f(rw.y); xv[4] = lo_f(rw.z); xv[5] = hi_f(rw.z); xv[6] = lo_f(rw.w); xv[7] = hi_f(rw.w);
#pragma unroll
        for (int k = 0; k < 4; ++k) { const int r = i - k;
            if (r >= 0 && r < 4) {
#pragma unroll
                for (int ch = 0; ch < 8; ++ch) out[r][ch] += w[k][ch] * xv[ch]; } } }
#pragma unroll
    for (int r = 0; r < 4; ++r) { const bool live = (pos0 + r) >= 0;
#pragma unroll
        for (int ch = 0; ch < 8; ++ch) out[r][ch] = live ? silu(out[r][ch]) : 0.f; }
}

__device__ __forceinline__ void ssd_phase(const Params& p, LAS unsigned char* lds) {
    const int tid = threadIdx.x, lane = tid & 63, w = __builtin_amdgcn_readfirstlane(tid >> 6), fr = lane & 15, fq = lane >> 4;
    constexpr int LP = 136;
    LAS bf16_t* Bs  = (LAS bf16_t*)lds;
    LAS bf16_t* Cs  = (LAS bf16_t*)(lds + 34816);
    LAS bf16_t* BsT = (LAS bf16_t*)(lds + 69632);
    LAS bf16_t* Xt  = (LAS bf16_t*)(lds + 104448);
    LAS bf16_t* Sl  = (LAS bf16_t*)(lds + 121856);
    LAS float* acs = (LAS float*)(lds + 139264); LAS float* dts = acs + 128; LAS float* wl = acs + 256;
    bf16_t* bufB = (bf16_t*)(p.ws + WS_BUF); const bf16_t* mxbc = (const bf16_t*)(p.ws + WS_MXBC);
    const float* dtb = (const float*)(p.ws + WS_DT); const float* mdt = (const float*)(p.ws + WS_MDT); float* ssq = (float*)(p.ws + WS_SSQ);
    for (int item = blockIdx.x; item < 256; item += gridDim.x) {
        const int b = item & 7, h = item >> 3, g = h >> 3;
        const float A_h = -__expf(p.a_log[h]), D_h = p.d_skip[h];
        f32x4 accS[4];
#pragma unroll
        for (int pt = 0; pt < 4; ++pt) accS[pt] = (f32x4){0.f, 0.f, 0.f, 0.f};
        __syncthreads();
        for (int i = tid; i < 64 * LP / 2; i += 512) ((LAS unsigned*)Sl)[i] = 0u;
#pragma unroll 1
        for (int c = 0; c < 17; ++c) {
            const int pos_base = (c == 0) ? -112 : 16 + 128 * (c - 1);
            if (w == 0) { float d0, d1;
                if (c == 0) { d0 = 0.f; d1 = (lane >= 48) ? mdt[(lane - 48) * 32 + h] : 0.f;
#ifdef DBG_NOMETA
                    d1 = 0.f;
#endif
                }
                else { const size_t rb = (size_t)(b * TSEQ + 128 * (c - 1)); d0 = dtb[(rb + lane) * 32 + h]; d1 = dtb[(rb + lane + 64) * 32 + h]; }
                float a0 = d0 * A_h, a1 = d1 * A_h;
#pragma unroll
                for (int o = 1; o < 64; o <<= 1) { const float t0 = __shfl_up(a0, o), t1 = __shfl_up(a1, o); if (lane >= o) { a0 += t0; a1 += t1; } }
                a1 += __shfl(a0, 63); const float alast = __shfl(a1, 63);
                acs[lane] = a0; acs[lane + 64] = a1; dts[lane] = d0; dts[lane + 64] = d1;
                wl[lane] = d0 * __expf(alast - a0); wl[lane + 64] = d1 * __expf(alast - a1); }
            __syncthreads();
#pragma unroll 1
            for (int hf = 0; hf < 2; ++hf) {
                const int t2 = tid & 255, r4 = 2 * (t2 >> 4) + hf, oc = t2 & 15; float o[4][8];
                if (tid < 256) { conv_block(p, bufB, mxbc, b, pos_base + 4 * r4, 2048 + 128 * g + 8 * oc, o);
#pragma unroll
                    for (int r = 0; r < 4; ++r) { u32x4 v; v.x = pk2(o[r][0], o[r][1]); v.y = pk2(o[r][2], o[r][3]); v.z = pk2(o[r][4], o[r][5]); v.w = pk2(o[r][6], o[r][7]); *(LAS u32x4*)(Bs + (4 * r4 + r) * LP + 8 * oc) = v; }
                    const f32x4 ww = *(const LAS f32x4*)(wl + 4 * r4);
#pragma unroll
                    for (int ch = 0; ch < 8; ++ch) { u32x2 v; v.x = pk2(o[0][ch] * ww[0], o[1][ch] * ww[1]); v.y = pk2(o[2][ch] * ww[2], o[3][ch] * ww[3]); *(LAS u32x2*)(BsT + (8 * oc + ch) * LP + 4 * r4) = v; } }
                else if (c > 0) { conv_block(p, bufB, mxbc, b, pos_base + 4 * r4, 2560 + 128 * g + 8 * oc, o);
#pragma unroll
                    for (int r = 0; r < 4; ++r) { u32x4 v; v.x = pk2(o[r][0], o[r][1]); v.y = pk2(o[r][2], o[r][3]); v.z = pk2(o[r][4], o[r][5]); v.w = pk2(o[r][6], o[r][7]); *(LAS u32x4*)(Cs + (4 * r4 + r) * LP + 8 * oc) = v; } }
            }
            if (tid < 256) { const int r4 = tid >> 3, oc = tid & 7; float o[4][8];
                conv_block(p, bufB, mxbc, b, pos_base + 4 * r4, 64 * h + 8 * oc, o);
#pragma unroll
                for (int ch = 0; ch < 8; ++ch) { u32x2 v; v.x = pk2(o[0][ch], o[1][ch]); v.y = pk2(o[2][ch], o[3][ch]); *(LAS u32x2*)(Xt + (8 * oc + ch) * LP + 4 * r4) = v; } }
            __syncthreads();
            f32x4 yv[4];
            const int l = 16 * w + fr;
            if (c > 0) {
                bf16x8 cf[4];
#pragma unroll
                for (int kn = 0; kn < 4; ++kn) cf[kn] = *(const LAS bf16x8*)(Cs + (16 * w + fr) * LP + 32 * kn + 8 * fq);
                f32x4 accO[4], accY[4];
#pragma unroll
                for (int pt = 0; pt < 4; ++pt) { accO[pt] = (f32x4){0.f, 0.f, 0.f, 0.f}; accY[pt] = (f32x4){0.f, 0.f, 0.f, 0.f};
#pragma unroll
                    for (int kn = 0; kn < 4; ++kn) { const bf16x8 a = *(const LAS bf16x8*)(Sl + (16 * pt + fr) * LP + 32 * kn + 8 * fq); accO[pt] = __builtin_amdgcn_mfma_f32_16x16x32_bf16(a, cf[kn], accO[pt], 0, 0, 0); } }
                const float acl = acs[l];
#pragma unroll 1
                for (int u = 0; 2 * u <= w; ++u) {
                    f32x4 m0 = {0.f, 0.f, 0.f, 0.f}, m1 = {0.f, 0.f, 0.f, 0.f};
#pragma unroll
                    for (int kn = 0; kn < 4; ++kn) { const bf16x8 a = *(const LAS bf16x8*)(Bs + (32 * u + fr) * LP + 32 * kn + 8 * fq); m0 = __builtin_amdgcn_mfma_f32_16x16x32_bf16(a, cf[kn], m0, 0, 0, 0); }
                    if (2 * u + 1 <= w) {
#pragma unroll
                        for (int kn = 0; kn < 4; ++kn) { const bf16x8 a = *(const LAS bf16x8*)(Bs + (32 * u + 16 + fr) * LP + 32 * kn + 8 * fq); m1 = __builtin_amdgcn_mfma_f32_16x16x32_bf16(a, cf[kn], m1, 0, 0, 0); } }
                    float v0[4], v1[4];
#pragma unroll
                    for (int jj = 0; jj < 4; ++jj) { const int s0 = 32 * u + 4 * fq + jj, s1 = s0 + 16;
                        const float e0 = (s0 <= l) ? __expf(acl - acs[s0]) * dts[s0] : 0.f, e1 = (s1 <= l) ? __expf(acl - acs[s1]) * dts[s1] : 0.f;
                        v0[jj] = (s0 <= l) ? m0[jj] * e0 : 0.f; v1[jj] = (s1 <= l) ? m1[jj] * e1 : 0.f;
                        if (s0 == l) v0[jj] += D_h; if (s1 == l) v1[jj] += D_h; }
                    u32x4 pw; pw.x = pk2(v0[0], v0[1]); pw.y = pk2(v0[2], v0[3]); pw.z = pk2(v1[0], v1[1]); pw.w = pk2(v1[2], v1[3]);
                    const bf16x8 pf = as_bf16x8(pw);
#pragma unroll
                    for (int pt = 0; pt < 4; ++pt) { const LAS bf16_t* xr = Xt + (16 * pt + fr) * LP + 32 * u + 4 * fq; const u32x2 x0 = *(const LAS u32x2*)xr, x1 = *(const LAS u32x2*)(xr + 16);
                        u32x4 xw; xw.x = x0.x; xw.y = x0.y; xw.z = x1.x; xw.w = x1.y;
                        accY[pt] = __builtin_amdgcn_mfma_f32_16x16x32_bf16(as_bf16x8(xw), pf, accY[pt], 0, 0, 0); } }
                const float el = __expf(acl);
#pragma unroll
                for (int pt = 0; pt < 4; ++pt) yv[pt] = accY[pt] + accO[pt] * el;
            }
            { const float elast = __expf(acs[127]);
#pragma unroll
              for (int pt = 0; pt < 4; ++pt) accS[pt] = accS[pt] * elast;
#pragma unroll
              for (int ul = 0; ul < 4; ++ul) { const bf16x8 bfr = *(const LAS bf16x8*)(BsT + (16 * w + fr) * LP + 32 * ul + 8 * fq);
#pragma unroll
                  for (int pt = 0; pt < 4; ++pt) { const bf16x8 a = *(const LAS bf16x8*)(Xt + (16 * pt + fr) * LP + 32 * ul + 8 * fq); accS[pt] = __builtin_amdgcn_mfma_f32_16x16x32_bf16(a, bfr, accS[pt], 0, 0, 0); } } }
            __syncthreads();
#pragma unroll
            for (int pt = 0; pt < 4; ++pt)
#pragma unroll
                for (int jj = 0; jj < 4; ++jj) Sl[(16 * pt + 4 * fq + jj) * LP + 16 * w + fr] = (bf16_t)(pk2(accS[pt][jj], 0.f) & 0xffffu);
            if (c > 0) { const size_t row = (size_t)(b * TSEQ + 128 * (c - 1) + l); bf16_t* zp = bufB + row * LDB_S + 64 * h; float ss = 0.f;
#pragma unroll
                for (int pt = 0; pt < 4; ++pt) { const u32x2 zz = *(const u32x2*)(zp + 16 * pt + 4 * fq);
                    const float y0 = yv[pt][0] * silu(lo_f(zz.x)), y1 = yv[pt][1] * silu(hi_f(zz.x)), y2 = yv[pt][2] * silu(lo_f(zz.y)), y3 = yv[pt][3] * silu(hi_f(zz.y));
                    ss += y0 * y0 + y1 * y1 + y2 * y2 + y3 * y3;
                    u32x2 o; o.x = pk2(y0, y1); o.y = pk2(y2, y3); *(u32x2*)(zp + 16 * pt + 4 * fq) = o; }
                ss += __shfl_xor(ss, 16); ss += __shfl_xor(ss, 32);
                if (fq == 0) ssq[row * 32 + h] = ss; }
        }
    }
}

__device__ __forceinline__ void gnorm_phase(const Params& p) {
    bf16_t* bufB = (bf16_t*)(p.ws + WS_BUF); const float* ssq = (const float*)(p.ws + WS_SSQ);
    const int nthr = gridDim.x * 512;
    for (int v = blockIdx.x * 512 + threadIdx.x; v < NROW * 256; v += nthr) { const int row = v >> 8, rem = v & 255, g = rem >> 6, oc = rem & 63;
        const f32x4 s0 = *(const f32x4*)(ssq + (size_t)row * 32 + 8 * g), s1 = *(const f32x4*)(ssq + (size_t)row * 32 + 8 * g + 4);
        const float rstd = rsqrtf(((s0[0] + s0[1]) + (s0[2] + s0[3]) + (s1[0] + s1[1]) + (s1[2] + s1[3])) * (1.f / 512.f) + EPS);
        bf16_t* ptr = bufB + (size_t)row * LDB_S + 512 * g + 8 * oc; const u32x4 a = *(const u32x4*)ptr; u32x4 o;
        o.x = pk2(lo_f(a.x) * rstd, hi_f(a.x) * rstd); o.y = pk2(lo_f(a.y) * rstd, hi_f(a.y) * rstd); o.z = pk2(lo_f(a.z) * rstd, hi_f(a.z) * rstd); o.w = pk2(lo_f(a.w) * rstd, hi_f(a.w) * rstd);
        *(u32x4*)ptr = o; }
}
__device__ __forceinline__ void final_phase(const Params& p) {
    const int lane = threadIdx.x & 63, wave = threadIdx.x >> 6; const float* of = (const float*)(p.ws + WS_BUF);
    for (int row = blockIdx.x * 8 + wave; row < NROW; row += gridDim.x * 8) { f32x4 v[4]; float s = 0.f;
#pragma unroll
        for (int i = 0; i < 4; ++i) { v[i] = *(const f32x4*)(of + (size_t)row * DM + 4 * lane + 256 * i); s += v[i][0] * v[i][0] + v[i][1] * v[i][1] + v[i][2] * v[i][2] + v[i][3] * v[i][3]; }
        const float rstd = rsqrtf(wave_sum(s) * (1.f / DM) + EPS);
#pragma unroll
        for (int i = 0; i < 4; ++i) { const f32x4 gg = *(const f32x4*)(p.g_post + 4 * lane + 256 * i), xx = *(const f32x4*)(p.x + (size_t)row * DM + 4 * lane + 256 * i);
            *(f32x4*)(p.out + (size_t)row * DM + 4 * lane + 256 * i) = xx + v[i] * rstd * gg; } }
}

__global__ void __launch_bounds__(512, 2) fwd_kernel(Params p) {
    extern __shared__ __attribute__((aligned(16))) unsigned char smem[];
    LAS unsigned char* lds = (LAS unsigned char*)smem;
    cg::grid_group grid = cg::this_grid();
    unsigned char* ws = p.ws; const int G = gridDim.x, lo = p.ph_lo, hi = p.ph_hi;
    bf16_t* buf = (bf16_t*)(ws + WS_BUF); bf16_t* U = (bf16_t*)(ws + WS_U); bf16_t* m1 = (bf16_t*)p.out;
#ifndef PHASE_MASK
#define PHASE_MASK 0x3ff
#endif
#define IN(k) ((((PHASE_MASK) >> (k)) & 1) && lo <= (k) && (k) < hi)
#define SEAM(k) do { if (IN(k) && IN((k) + 1)) { asm volatile("s_waitcnt vmcnt(0) lgkmcnt(0)" ::: "memory"); grid.sync(); } } while (0)
    if (IN(0)) prep_phase(p, lds);
    SEAM(0);
    if (IN(1)) { pg8::Gemm g{U, (const bf16_t*)(ws + WS_WT_ATT), NROW, NATT, DM, DM, DM}; pg8::StaticOrder S; S.init(NROW, NATT, G, (int)blockIdx.x);
        EpiAtt E{buf, (float*)(ws + WS_DT), p.dt_bias}; pg8::gemm_phase<EpiAtt, pg8::StaticOrder>(lds, g, S, E, nullptr); }
    SEAM(1);
    if (IN(2)) attn_phase(p, lds);
    SEAM(2);
    if (IN(3)) { pg8::Gemm g{buf, (const bf16_t*)(ws + WS_WOA), NROW, DM, DM, LDA_A, DM}; pg8::StaticOrder S; S.init(NROW, DM, G, (int)blockIdx.x);
        EpiYatt E{buf, m1}; pg8::gemm_phase<EpiYatt, pg8::StaticOrder>(lds, g, S, E, nullptr); }
    SEAM(3);
    if (IN(4)) { pg8::Gemm g{U, (const bf16_t*)(ws + WS_WT_SSM), NROW, LDB_S, DM, DM, DM}; pg8::StaticOrder S; S.init(NROW, LDB_S, G, (int)blockIdx.x);
        EpiStore E{buf, LDB_S}; pg8::gemm_phase<EpiStore, pg8::StaticOrder>(lds, g, S, E, nullptr); }
    SEAM(4);
    if (IN(5)) ssd_phase(p, lds);
    SEAM(5);
    if (IN(6)) gnorm_phase(p);
    SEAM(6);
    if (IN(7)) { pg8::Gemm g{buf, (const bf16_t*)(ws + WS_WOS), NROW, DM, 2048, LDB_S, 2048}; pg8::StaticOrder S; S.init(NROW, DM, G, (int)blockIdx.x);
        EpiYssm E{buf, m1, U}; pg8::gemm_phase<EpiYssm, pg8::StaticOrder>(lds, g, S, E, nullptr); }
    SEAM(7);
    if (IN(8)) { pg8::Gemm g{U, (const bf16_t*)(ws + WS_WO), NROW, DM, DM, DM, DM}; pg8::StaticOrder S; S.init(NROW, DM, G, (int)blockIdx.x);
        EpiF32 E{(float*)buf, DM}; pg8::gemm_phase<EpiF32, pg8::StaticOrder>(lds, g, S, E, nullptr); }
    SEAM(8);
    if (IN(9)) final_phase(p);

#ifdef DBG_STOP
    { asm volatile("s_waitcnt vmcnt(0) lgkmcnt(0)" ::: "memory"); grid.sync();
      const float* dtb = (const float*)(ws + WS_DT); const float* ssq = (const float*)(ws + WS_SSQ);
      const bf16_t* wa = (const bf16_t*)(ws + WS_WT_ATT); const bf16_t* wsm = (const bf16_t*)(ws + WS_WT_SSM); const bf16_t* woa = (const bf16_t*)(ws + WS_WOA); const bf16_t* wos = (const bf16_t*)(ws + WS_WOS); const bf16_t* wo = (const bf16_t*)(ws + WS_WO);
      const bf16_t* mkv = (const bf16_t*)(ws + WS_MKV); const bf16_t* mxbc = (const bf16_t*)(ws + WS_MXBC); const float* mdt = (const float*)(ws + WS_MDT);
      for (size_t i = (size_t)blockIdx.x * 512 + threadIdx.x; i < (size_t)NROW * DM; i += (size_t)G * 512) { const size_t r = i >> 10; const int c = (int)(i & 1023); float v = 0.f;
#define BF(ptr, idx) __uint_as_float(((unsigned)(ptr)[idx]) << 16)
          if (DBG_KIND == 0) v = BF(U, i) + BF(wa, (r % 3840) * 1024 + c) + BF(wsm, (r % 6144) * 1024 + c) + BF(woa, (r & 1023) * 1024 + c) + BF(wos, (r & 1023) * 2048 + c) + BF(wos, (r & 1023) * 2048 + 1024 + c) + BF(wo, (r & 1023) * 1024 + c)
                               + BF(mkv, (r & 15) * 512 + (c & 511)) + BF(mxbc, (r & 15) * 3072 + c + 1024 * ((r >> 4) % 3)) + mdt[(r & 15) * 32 + (c & 31)];
          if (DBG_KIND == 1) v = BF(buf, r * LDA_A + c) + BF(buf, r * LDA_A + 1024 + c) + BF(buf, r * LDA_A + 2048 + c) + BF(buf, r * LDA_A + 3072 + (c & 511)) + dtb[r * 32 + (c & 31)];
          if (DBG_KIND == 2) v = BF(buf, r * LDB_S + c) + BF(buf, r * LDB_S + 1024 + c) + BF(buf, r * LDB_S + 2048 + c) + BF(buf, r * LDB_S + 3072 + c) + BF(buf, r * LDB_S + 4096 + c) + BF(buf, r * LDB_S + 5120 + c) + ssq[r * 32 + (c & 31)];
          if (DBG_KIND == 5) v = BF(buf, r * LDB_S + c) + BF(buf, r * LDB_S + 1024 + c) + BF(buf, r * LDB_S + 2048 + c) + BF(buf, r * LDB_S + 3072 + c) + BF(buf, r * LDB_S + 4096 + c) + BF(buf, r * LDB_S + 5120 + c);
          if (DBG_KIND == 3) v = BF(U, i);
          if (DBG_KIND == 4) v = ((const float*)buf)[i];
          p.out[i] = v; }
    }
#endif
}
}

extern "C" void kernel_launch(void* const* d_in, const int* in_sizes, int n_in, void* d_out, int out_size, void* d_ws, size_t ws_size, hipStream_t stream) {
    using namespace mk;
    static int grid = 0;
    if (grid == 0) {
        if (n_in != 15 || out_size != NROW * DM || ws_size < WS_END) { fprintf(stderr, "kernel_launch: unexpected shapes (n_in %d out %d ws %zu need %zu)\n", n_in, out_size, ws_size, (size_t)WS_END); grid = -1; return; }
        int dev = 0, cus = 0, per_cu = 0;
        (void)hipGetDevice(&dev); (void)hipDeviceGetAttribute(&cus, hipDeviceAttributeMultiprocessorCount, dev);
        if (hipFuncSetAttribute((const void*)fwd_kernel, hipFuncAttributeMaxDynamicSharedMemorySize, LDS_BYTES) != hipSuccess) { fprintf(stderr, "kernel_launch: hipFuncSetAttribute failed\n"); grid = -1; return; }
        if (hipOccupancyMaxActiveBlocksPerMultiprocessor(&per_cu, (const void*)fwd_kernel, 512, LDS_BYTES) != hipSuccess || per_cu < 1) { fprintf(stderr, "kernel_launch: occupancy query gives %d\n", per_cu); (void)hipGetLastError(); grid = -1; return; }
        grid = cus;
    }
    if (grid < 0) return;
    Params p{};
    p.x = (const float*)d_in[0]; p.meta = (const float*)d_in[1]; p.g_pre = (const float*)d_in[2]; p.w_in = (const float*)d_in[3]; p.conv_w = (const float*)d_in[4]; p.conv_b = (const float*)d_in[5];
    p.dt_bias = (const float*)d_in[6]; p.a_log = (const float*)d_in[7]; p.d_skip = (const float*)d_in[8]; p.sinks = (const float*)d_in[9]; p.g_ssm = (const float*)d_in[10];
    p.w_oa = (const float*)d_in[11]; p.w_os = (const float*)d_in[12]; p.w_o = (const float*)d_in[13]; p.g_post = (const float*)d_in[14];
    p.out = (float*)d_out; p.ws = (unsigned char*)d_ws; p.ph_lo = 0; p.ph_hi = 10;
#ifdef DBG_STOP
    p.ph_hi = DBG_STOP + 1;
#endif
    void* args[] = {&p};
    hipError_t e = hipLaunchCooperativeKernel((const void*)fwd_kernel, dim3(grid), dim3(512), args, LDS_BYTES, stream);
    if (e != hipSuccess) fprintf(stderr, "kernel_launch: cooperative launch failed: %s (grid %d)\n", hipGetErrorString(e), grid);
}
```

```cpp
#include <hip/hip_runtime.h>
#include <hip/hip_cooperative_groups.h>
#include <cstdio>
namespace cg = cooperative_groups;

namespace pg8 {
#define PG8_LAS __attribute__((address_space(3)))
typedef unsigned short bf16_t;
typedef short bf16x8 __attribute__((ext_vector_type(8)));
typedef float f32x4 __attribute__((ext_vector_type(4)));
typedef unsigned u32x4 __attribute__((ext_vector_type(4)));
constexpr int BM = 256, BK = 64, HALF = 128, HTB = HALF * BK * 2  , STAGE_BYTES = 8 * HTB, NXCD = 8, WGM = 2;

__host__ __device__ __forceinline__ int lds_byte(int r, int c) { const int st = (r >> 4) * 2 + (c >> 5), rr = r & 15, cc = c & 31, ob = rr * 64 + cc * 2; return st * 1024 + (ob ^ (((ob >> 9) & 1) << 5)); }
__host__ __device__ __forceinline__ void stage_rc(int b, int& R, int& C) { const int st = b / 1024, sb = b % 1024, swz = sb ^ (((sb >> 9) & 1) << 5); R = (st >> 1) * 16 + swz / 64; C = (st & 1) * 32 + (swz % 64) / 2; }
__host__ __device__ __forceinline__ int perm32(int rho) { const int n = rho >> 4, i = rho & 15; return 8 * (i >> 2) + 4 * n + (i & 3); }

struct Unit { int pm, pn; };
struct Gemm { const bf16_t* A; const bf16_t* Bt; int M, N, K, lda, ldb; };

struct StaticOrder {
    int nM, nN, nwg, G, c;
    __host__ __device__ void init(int M, int N, int G_, int c_) { nM = M / BM; nN = N / BM; nwg = nM * nN; G = G_; c = c_; }
    __host__ __device__ bool next(int i, Unit& u) const {
        const long L = (long)i * G + c; if (L >= nwg) return false;
        int wgid = (int)L; { const int q = nwg / NXCD, r = nwg % NXCD, xcd = wgid % NXCD, off = wgid / NXCD; wgid = (xcd < r ? xcd * (q + 1) : r * (q + 1) + (xcd - r) * q) + off; }
        const int nig = WGM * nN, gid = wgid / nig, fm = gid * WGM, gsz = (nM - fm) < WGM ? (nM - fm) : WGM;
        u.pm = fm + ((wgid % nig) % gsz); u.pn = (wgid % nig) / gsz; return true;
    }
    __device__ __forceinline__ void a_ready(const Unit&) const {}
    __device__ __forceinline__ void done(const Unit&) const {}
};
template <class Epi, class Sched, bool STAMP = false, bool GSC = false>
__device__ __forceinline__ void gemm_phase(PG8_LAS unsigned char* lds, const Gemm g, const Sched& S, const Epi& E, unsigned long long* stamps, const PG8_LAS float* gtab = nullptr) {
    const int tid = threadIdx.x, wid = __builtin_amdgcn_readfirstlane(tid >> 6), lane = tid & 63, wr = wid >> 2, wc = wid & 3, fr = lane & 15, fq = lane >> 4;
    const int K = g.K, nt = K / BK;
    int ts_lo = 0, ts_hi = 0, nts = 0; const unsigned long long rt_entry = STAMP ? (unsigned long long)wall_clock64() : 0ull;
#define PG8_STAMP() do { if (STAMP && wid == 0 && nts < 64) { const unsigned long long _c = (unsigned long long)clock64(); \
        ts_lo = (lane == nts) ? (int)(unsigned)_c : ts_lo; ts_hi = (lane == nts) ? (int)(unsigned)(_c >> 32) : ts_hi; ++nts; } } while (0)
    PG8_STAMP();
    unsigned voffA[2], voffB[2];
#pragma unroll
    for (int i = 0; i < 2; ++i) { int R, C; stage_rc(tid * 16 + i * 8192, R, C); const int Rb = Epi::PERM ? ((R & ~31) + perm32(R & 31)) : R;
        voffA[i] = (unsigned)(R * g.lda + C) * 2u; voffB[i] = (unsigned)(Rb * g.ldb + C) * 2u; }
    const size_t kstep = (size_t)(BK * 2);
    const size_t hstepA = (size_t)HALF * g.lda * 2, hstepB = (size_t)HALF * g.ldb * 2;
    const size_t tstepA = 2 * hstepA, tstepB = 2 * hstepB;
    const unsigned ldsw = (unsigned)wid * 1024u;
    const int aoff = lds_byte(wr * 64 + fr, fq * 8), boff = lds_byte(wc * 32 + fr, fq * 8);
#define PG8_SA(b, h) (((b) * 2 + (h)) * HTB)
#define PG8_SB(b, h) ((4 + (b) * 2 + (h)) * HTB)
#define PG8_STAGE(bufoff, gbase, voff) do { _Pragma("unroll") for (int _i = 0; _i < 2; ++_i) \
        __builtin_amdgcn_global_load_lds((const unsigned*)((const char*)(gbase) + (voff)[_i]), (PG8_LAS unsigned*)(lds + (bufoff) + ldsw + _i * 8192), 16, 0, 0); } while (0)
#define PG8_LDA(dst, b, h) do { _Pragma("unroll") for (int m = 0; m < 4; ++m) _Pragma("unroll") for (int k = 0; k < 2; ++k) dst[m][k] = *(const PG8_LAS bf16x8*)(lds + PG8_SA(b, h) + aoff + m * 2048 + k * 1024); } while (0)
#define PG8_LDB(dst, b, h) do { _Pragma("unroll") for (int n = 0; n < 2; ++n) _Pragma("unroll") for (int k = 0; k < 2; ++k) dst[n][k] = *(const PG8_LAS bf16x8*)(lds + PG8_SB(b, h) + boff + n * 2048 + k * 1024); } while (0)
#define PG8_MMA(ai, bj, At, Bt) do { __builtin_amdgcn_s_setprio(1); _Pragma("unroll") for (int m = 0; m < 4; ++m) _Pragma("unroll") for (int n = 0; n < 2; ++n) _Pragma("unroll") for (int k = 0; k < 2; ++k) \
        acc[ai][bj][m][n] = __builtin_amdgcn_mfma_f32_16x16x32_bf16(Bt[n][k], At[m][k], acc[ai][bj][m][n], 0, 0, 0); __builtin_amdgcn_s_setprio(0); } while (0)
#define PG8_WAIT_V(n) asm volatile("s_waitcnt vmcnt(" #n ")" ::: "memory")
#define PG8_WAIT_L(n) asm volatile("s_waitcnt lgkmcnt(" #n ")" ::: "memory")
#define PG8_BAR __builtin_amdgcn_s_barrier()
#define PG8_SCHED __builtin_amdgcn_sched_barrier(0)
    Unit cur, nxt; int ui = 0;
    if (!S.next(0, cur)) return;
    f32x4 acc[2][2][4][2];
#pragma unroll
    for (int a = 0; a < 2; ++a)
#pragma unroll
        for (int b = 0; b < 2; ++b)
#pragma unroll
            for (int m = 0; m < 4; ++m)
#pragma unroll
                for (int n = 0; n < 2; ++n) acc[a][b][m][n] = (f32x4){0.f, 0.f, 0.f, 0.f};
    bf16x8 At[4][2], B0[2][2], B1[2][2];
    const char* cA = (const char*)g.A + (size_t)cur.pm * tstepA; const char* cB = (const char*)g.Bt + (size_t)cur.pn * tstepB;
    S.a_ready(cur);
    PG8_STAGE(PG8_SB(0, 0), cB, voffB); PG8_STAGE(PG8_SA(0, 0), cA, voffA); PG8_STAGE(PG8_SB(0, 1), cB + hstepB, voffB); PG8_STAGE(PG8_SA(0, 1), cA + hstepA, voffA);
    if (wr == 1) PG8_BAR;
    PG8_WAIT_V(4); PG8_BAR;
    PG8_STAGE(PG8_SB(1, 0), cB + kstep, voffB); PG8_STAGE(PG8_SA(1, 0), cA + kstep, voffA); PG8_STAGE(PG8_SB(1, 1), cB + hstepB + kstep, voffB);
    PG8_WAIT_V(6); PG8_BAR;
    PG8_STAMP();
    for (;;) {
        const bool has_next = S.next(ui + 1, nxt);
        const char* nA = has_next ? (const char*)g.A + (size_t)nxt.pm * tstepA : cA; const char* nB = has_next ? (const char*)g.Bt + (size_t)nxt.pn * tstepB : cB;
        for (int tg = 0; tg < nt; tg += (GSC ? 8 : nt)) {
        if constexpr (GSC) { if (tg > 0) { const PG8_LAS float* gt = gtab + ((tg >> 3) - 1) * 256 + wr * 64 + fr;
#pragma unroll
            for (int ai = 0; ai < 2; ++ai)
#pragma unroll
                for (int m = 0; m < 4; ++m) { const float rt = gt[ai * HALF + m * 16];
#pragma unroll
                    for (int bj = 0; bj < 2; ++bj)
#pragma unroll
                        for (int n = 0; n < 2; ++n) acc[ai][bj][m][n] = acc[ai][bj][m][n] * rt;
                    PG8_SCHED; }
            PG8_WAIT_L(0); PG8_SCHED; } }
        const int tend = GSC ? tg + 8 : nt;
        for (int t = tg; t < tend; t += 2) {
            const bool last = (t == nt - 2);
            const char* a1 = cA + (size_t)(t + 1) * kstep;
            const char* a2 = last ? nA : cA + (size_t)(t + 2) * kstep; const char* b2 = last ? nB : cB + (size_t)(t + 2) * kstep;
            const char* a3 = a2 + kstep; const char* b3 = b2 + kstep;
            if (last && has_next) S.a_ready(nxt);
            PG8_LDB(B0, 0, 0); PG8_SCHED; PG8_LDA(At, 0, 0); PG8_STAGE(PG8_SA(1, 1), a1 + hstepA, voffA);
            PG8_WAIT_L(8); PG8_BAR; PG8_WAIT_L(0); PG8_MMA(0, 0, At, B0); PG8_BAR; PG8_SCHED;
            PG8_LDB(B1, 0, 1); PG8_STAGE(PG8_SB(0, 0), b2, voffB);
            PG8_BAR; PG8_WAIT_L(0); PG8_MMA(0, 1, At, B1); PG8_BAR;
            PG8_LDA(At, 0, 1); PG8_STAGE(PG8_SA(0, 0), a2, voffA);
            PG8_BAR; PG8_WAIT_L(0); PG8_MMA(1, 0, At, B0); PG8_BAR; PG8_SCHED;
            PG8_STAGE(PG8_SB(0, 1), b2 + hstepB, voffB);
            PG8_WAIT_V(6); PG8_BAR; PG8_MMA(1, 1, At, B1); PG8_BAR;
            PG8_LDB(B0, 1, 0); PG8_SCHED; PG8_LDA(At, 1, 0); PG8_STAGE(PG8_SA(0, 1), a2 + hstepA, voffA);
            PG8_WAIT_L(8); PG8_BAR; PG8_WAIT_L(0); PG8_MMA(0, 0, At, B0); PG8_BAR; PG8_SCHED;
            PG8_LDB(B1, 1, 1); PG8_STAGE(PG8_SB(1, 0), b3, voffB);
            PG8_BAR; PG8_WAIT_L(0); PG8_MMA(0, 1, At, B1); PG8_BAR;
            PG8_LDA(At, 1, 1); PG8_STAGE(PG8_SA(1, 0), a3, voffA);
            PG8_BAR; PG8_WAIT_L(0); PG8_MMA(1, 0, At, B0); PG8_BAR; PG8_SCHED;
            PG8_STAGE(PG8_SB(1, 1), b3 + hstepB, voffB);
            PG8_WAIT_V(6); PG8_BAR; PG8_MMA(1, 1, At, B1); PG8_BAR;
        }
        }
        PG8_STAMP();
        if constexpr (GSC) { const PG8_LAS float* gt = gtab + 3 * 256 + wr * 64 + fr;
#pragma unroll
            for (int ai = 0; ai < 2; ++ai)
#pragma unroll
                for (int m = 0; m < 4; ++m) { const float rt = gt[ai * HALF + m * 16];
#pragma unroll
                    for (int bj = 0; bj < 2; ++bj)
#pragma unroll
                        for (int n = 0; n < 2; ++n) acc[ai][bj][m][n] = acc[ai][bj][m][n] * rt;
                    PG8_SCHED; } }
        if constexpr (!Epi::AFTER_DRAIN) { E(acc, cur, wr, wc, fr, fq); S.done(cur); }
        PG8_STAMP();
        if (!has_next) break;
#pragma unroll
        for (int a = 0; a < 2; ++a)
#pragma unroll
            for (int b = 0; b < 2; ++b)
#pragma unroll
                for (int m = 0; m < 4; ++m)
#pragma unroll
                    for (int n = 0; n < 2; ++n) acc[a][b][m][n] = (f32x4){0.f, 0.f, 0.f, 0.f};
        cur = nxt; cA = nA; cB = nB; ++ui;
    }
    PG8_WAIT_V(0);
    if (wr == 0) PG8_BAR;
    PG8_BAR;
    if constexpr (Epi::AFTER_DRAIN) { E.fused(acc, cur, wr, wc, fr, fq, lds, wid, lane); S.done(cur); }
    PG8_STAMP();
    if (STAMP && wid == 0) { stamps[lane] = lane < nts ? (((unsigned long long)(unsigned)ts_hi << 32) | (unsigned)ts_lo) : 0ull;
        if (lane == 62) stamps[62] = rt_entry; if (lane == 63) stamps[63] = (unsigned long long)wall_clock64(); }
#undef PG8_STAMP
#undef PG8_SA
#undef PG8_SB
#undef PG8_STAGE
#undef PG8_LDA
#undef PG8_LDB
#undef PG8_MMA
#undef PG8_WAIT_V
#undef PG8_WAIT_L
#undef PG8_BAR
#undef PG8_SCHED
}
template <class Epi, class Sched, bool ALIGN_EPI = false, bool SP2 = false, bool GSC = false>
__device__ __forceinline__ void gemm_phase2(PG8_LAS unsigned char* lds, const Gemm g, const Sched& S, const Epi& E, const PG8_LAS float* gtab = nullptr) {
    const int tid = threadIdx.x, wid = __builtin_amdgcn_readfirstlane(tid >> 6), lane = tid & 63, wr = wid >> 2, wc = wid & 3, fr = lane & 15, fq = lane >> 4;
    const int K = g.K, nt = K / BK;
    unsigned voffA[2], voffB[2];
#pragma unroll
    for (int i = 0; i < 2; ++i) { int R, C; stage_rc(tid * 16 + i * 8192, R, C); const int Rb = Epi::PERM ? ((R & ~31) + perm32(R & 31)) : R;
        voffA[i] = (unsigned)(R * g.lda + C) * 2u; voffB[i] = (unsigned)(Rb * g.ldb + C) * 2u; }
    const size_t kstep = (size_t)(BK * 2);
    const size_t hstepA = (size_t)HALF * g.lda * 2, hstepB = (size_t)HALF * g.ldb * 2;
    const size_t tstepA = 2 * hstepA, tstepB = 2 * hstepB;
    const unsigned ldsw = (unsigned)wid * 1024u;
    const int aoff = lds_byte(wr * 64 + fr, fq * 8), boff = lds_byte(wc * 32 + fr, fq * 8);
#define PG8_SA(b, h) (((b) * 2 + (h)) * HTB)
#define PG8_SB(b, h) ((4 + (b) * 2 + (h)) * HTB)
#define PG8_STAGE(bufoff, gbase, voff) do { _Pragma("unroll") for (int _i = 0; _i < 2; ++_i) \
        __builtin_amdgcn_global_load_lds((const unsigned*)((const char*)(gbase) + (voff)[_i]), (PG8_LAS unsigned*)(lds + (bufoff) + ldsw + _i * 8192), 16, 0, 0); } while (0)
#define PG8_LDA(dst, b, h) do { _Pragma("unroll") for (int m = 0; m < 4; ++m) _Pragma("unroll") for (int k = 0; k < 2; ++k) dst[m][k] = *(const PG8_LAS bf16x8*)(lds + PG8_SA(b, h) + aoff + m * 2048 + k * 1024); } while (0)
#define PG8_LDB(dst, b, h) do { _Pragma("unroll") for (int n = 0; n < 2; ++n) _Pragma("unroll") for (int k = 0; k < 2; ++k) dst[n][k] = *(const PG8_LAS bf16x8*)(lds + PG8_SB(b, h) + boff + n * 2048 + k * 1024); } while (0)
#define PG8_MMA(ai, bj, At, Bt) do { __builtin_amdgcn_s_setprio(1); _Pragma("unroll") for (int m = 0; m < 4; ++m) _Pragma("unroll") for (int n = 0; n < 2; ++n) _Pragma("unroll") for (int k = 0; k < 2; ++k) \
        acc[ai][bj][m][n] = __builtin_amdgcn_mfma_f32_16x16x32_bf16(Bt[n][k], At[m][k], acc[ai][bj][m][n], 0, 0, 0); __builtin_amdgcn_s_setprio(0); } while (0)
#define PG8_WAIT_V(n) asm volatile("s_waitcnt vmcnt(" #n ")" ::: "memory")
#define PG8_WAIT_L(n) asm volatile("s_waitcnt lgkmcnt(" #n ")" ::: "memory")
#define PG8_BAR __builtin_amdgcn_s_barrier()
#define PG8_SCHED __builtin_amdgcn_sched_barrier(0)
    Unit cur, nxt; int ui = 0;
    if (!S.next(0, cur)) return;
    f32x4 acc[2][2][4][2];
#pragma unroll
    for (int a = 0; a < 2; ++a)
#pragma unroll
        for (int b = 0; b < 2; ++b)
#pragma unroll
            for (int m = 0; m < 4; ++m)
#pragma unroll
                for (int n = 0; n < 2; ++n) acc[a][b][m][n] = (f32x4){0.f, 0.f, 0.f, 0.f};
    bf16x8 At[4][2], B0[2][2], B1[2][2];
    const char* cA = (const char*)g.A + (size_t)cur.pm * tstepA; const char* cB = (const char*)g.Bt + (size_t)cur.pn * tstepB;
    S.a_ready(cur);
    if constexpr (SP2) {
        PG8_STAGE(PG8_SB(0, 0), cB, voffB); PG8_STAGE(PG8_SB(0, 1), cB + hstepB, voffB); PG8_STAGE(PG8_SA(0, 0), cA, voffA); PG8_STAGE(PG8_SA(0, 1), cA + hstepA, voffA);
        if (wr == 1) PG8_BAR;
        PG8_WAIT_V(2); PG8_BAR;
        PG8_STAGE(PG8_SB(1, 0), cB + kstep, voffB); PG8_STAGE(PG8_SA(1, 0), cA + kstep, voffA); PG8_STAGE(PG8_SB(1, 1), cB + hstepB + kstep, voffB);
        PG8_WAIT_V(6); PG8_BAR;
    } else {
        PG8_STAGE(PG8_SB(0, 0), cB, voffB); PG8_STAGE(PG8_SA(0, 0), cA, voffA); PG8_STAGE(PG8_SB(0, 1), cB + hstepB, voffB); PG8_STAGE(PG8_SA(0, 1), cA + hstepA, voffA);
        if (wr == 1) PG8_BAR;
        PG8_WAIT_V(4); PG8_BAR;
        PG8_STAGE(PG8_SB(1, 0), cB + kstep, voffB); PG8_STAGE(PG8_SA(1, 0), cA + kstep, voffA); PG8_STAGE(PG8_SB(1, 1), cB + hstepB + kstep, voffB);
        PG8_WAIT_V(6); PG8_BAR;
    }
    for (;;) {
        const bool has_next = S.next(ui + 1, nxt);
        const char* nA = has_next ? (const char*)g.A + (size_t)nxt.pm * tstepA : cA; const char* nB = has_next ? (const char*)g.Bt + (size_t)nxt.pn * tstepB : cB;
        for (int tg = 0; tg < nt; tg += (GSC ? 8 : nt)) {
        if constexpr (GSC) { if (tg > 0) { const PG8_LAS float* gt = gtab + ((tg >> 3) - 1) * 256 + wr * 64 + fr;
#pragma unroll
            for (int ai = 0; ai < 2; ++ai)
#pragma unroll
                for (int m = 0; m < 4; ++m) { const float rt = gt[ai * HALF + m * 16];
#pragma unroll
                    for (int bj = 0; bj < 2; ++bj)
#pragma unroll
                        for (int n = 0; n < 2; ++n) acc[ai][bj][m][n] = acc[ai][bj][m][n] * rt;
                    PG8_SCHED; }
            PG8_WAIT_L(0); PG8_SCHED; } }
        const int tend = GSC ? tg + 8 : nt;
        for (int t = tg; t < tend; t += 2) {
            const bool last = (t == nt - 2);
            const char* a1 = cA + (size_t)(t + 1) * kstep;
            const char* a2 = last ? nA : cA + (size_t)(t + 2) * kstep; const char* b2 = last ? nB : cB + (size_t)(t + 2) * kstep;
            const char* a3 = a2 + kstep; const char* b3 = b2 + kstep;
            if (last && has_next) S.a_ready(nxt);
            if constexpr (SP2) {
            PG8_LDB(B0, 0, 0); PG8_LDB(B1, 0, 1); PG8_SCHED; PG8_LDA(At, 0, 0); PG8_STAGE(PG8_SA(1, 1), a1 + hstepA, voffA);
            PG8_WAIT_V(8); PG8_WAIT_L(0); PG8_BAR; PG8_MMA(0, 0, At, B0); PG8_MMA(0, 1, At, B1); PG8_BAR; PG8_SCHED;
            PG8_LDA(At, 0, 1); PG8_STAGE(PG8_SB(0, 0), b2, voffB); PG8_STAGE(PG8_SB(0, 1), b2 + hstepB, voffB); PG8_STAGE(PG8_SA(0, 0), a2, voffA);
            PG8_WAIT_V(8); PG8_WAIT_L(0); PG8_BAR; PG8_MMA(1, 0, At, B0); PG8_MMA(1, 1, At, B1); PG8_BAR; PG8_SCHED;
            PG8_LDB(B0, 1, 0); PG8_LDB(B1, 1, 1); PG8_SCHED; PG8_LDA(At, 1, 0); PG8_STAGE(PG8_SA(0, 1), a2 + hstepA, voffA);
            PG8_WAIT_V(8); PG8_WAIT_L(0); PG8_BAR; PG8_MMA(0, 0, At, B0); PG8_MMA(0, 1, At, B1); PG8_BAR; PG8_SCHED;
            PG8_LDA(At, 1, 1); PG8_STAGE(PG8_SB(1, 0), b3, voffB); PG8_STAGE(PG8_SB(1, 1), b3 + hstepB, voffB); PG8_STAGE(PG8_SA(1, 0), a3, voffA);
            PG8_WAIT_V(8); PG8_WAIT_L(0); PG8_BAR; PG8_MMA(1, 0, At, B0); PG8_MMA(1, 1, At, B1); PG8_BAR; PG8_SCHED;
            } else {
            PG8_LDB(B0, 0, 0); PG8_SCHED; PG8_LDA(At, 0, 0); PG8_STAGE(PG8_SA(1, 1), a1 + hstepA, voffA);
            PG8_WAIT_L(8); PG8_BAR; PG8_WAIT_L(0); PG8_MMA(0, 0, At, B0); PG8_BAR; PG8_SCHED;
            PG8_LDB(B1, 0, 1); PG8_STAGE(PG8_SB(0, 0), b2, voffB);
            PG8_BAR; PG8_WAIT_L(0); PG8_MMA(0, 1, At, B1); PG8_BAR;
            PG8_LDA(At, 0, 1); PG8_STAGE(PG8_SA(0, 0), a2, voffA);
            PG8_BAR; PG8_WAIT_L(0); PG8_MMA(1, 0, At, B0); PG8_BAR; PG8_SCHED;
            PG8_STAGE(PG8_SB(0, 1), b2 + hstepB, voffB);
            PG8_WAIT_V(6); PG8_BAR; PG8_MMA(1, 1, At, B1); PG8_BAR;
            PG8_LDB(B0, 1, 0); PG8_SCHED; PG8_LDA(At, 1, 0); PG8_STAGE(PG8_SA(0, 1), a2 + hstepA, voffA);
            PG8_WAIT_L(8); PG8_BAR; PG8_WAIT_L(0); PG8_MMA(0, 0, At, B0); PG8_BAR; PG8_SCHED;
            PG8_LDB(B1, 1, 1); PG8_STAGE(PG8_SB(1, 0), b3, voffB);
            PG8_BAR; PG8_WAIT_L(0); PG8_MMA(0, 1, At, B1); PG8_BAR;
            PG8_LDA(At, 1, 1); PG8_STAGE(PG8_SA(1, 0), a3, voffA);
            PG8_BAR; PG8_WAIT_L(0); PG8_MMA(1, 0, At, B0); PG8_BAR; PG8_SCHED;
            PG8_STAGE(PG8_SB(1, 1), b3 + hstepB, voffB);
            PG8_WAIT_V(6); PG8_BAR; PG8_MMA(1, 1, At, B1); PG8_BAR;
            }
        }
        }
        if constexpr (GSC) { const PG8_LAS float* gt = gtab + 3 * 256 + wr * 64 + fr;
#pragma unroll
            for (int ai = 0; ai < 2; ++ai)
#pragma unroll
                for (int m = 0; m < 4; ++m) { const float rt = gt[ai * HALF + m * 16];
#pragma unroll
                    for (int bj = 0; bj < 2; ++bj)
#pragma unroll
                        for (int n = 0; n < 2; ++n) acc[ai][bj][m][n] = acc[ai][bj][m][n] * rt;
                    PG8_SCHED; } }
        if constexpr (ALIGN_EPI) { if (wr == 0) PG8_BAR; }
        if constexpr (!Epi::AFTER_DRAIN) { E(acc, cur, wr, wc, fr, fq); S.done(cur); }
        if (!has_next) break;
#pragma unroll
        for (int a = 0; a < 2; ++a)
#pragma unroll
            for (int b = 0; b < 2; ++b)
#pragma unroll
                for (int m = 0; m < 4; ++m)
#pragma unroll
                    for (int n = 0; n < 2; ++n) acc[a][b][m][n] = (f32x4){0.f, 0.f, 0.f, 0.f};
        cur = nxt; cA = nA; cB = nB; ++ui;
        if constexpr (ALIGN_EPI) { if (wr == 1) PG8_BAR; }
    }
    PG8_WAIT_V(0);
    if constexpr (!ALIGN_EPI) { if (wr == 0) PG8_BAR; }
    PG8_BAR;
    if constexpr (Epi::AFTER_DRAIN) { E.fused(acc, cur, wr, wc, fr, fq, lds, wid, lane); S.done(cur); }
#undef PG8_SA
#undef PG8_SB
#undef PG8_STAGE
#undef PG8_LDA
#undef PG8_LDB
#undef PG8_MMA
#undef PG8_WAIT_V
#undef PG8_WAIT_L
#undef PG8_BAR
#undef PG8_SCHED
}
}

namespace mk {
using pg8::bf16_t; using pg8::bf16x8; using pg8::f32x4; using pg8::u32x4;
#define LAS __attribute__((address_space(3)))
typedef unsigned u32x2 __attribute__((ext_vector_type(2)));

constexpr int DM = 1024, NBATCH = 8, TSEQ = 2048, NROW = NBATCH * TSEQ;
constexpr int NIN = 9760;
constexpr int LDA_A = 3584;
constexpr int NATT = 3840;
constexpr int LDB_S = 6144;
constexpr float EPS = 1e-6f;
constexpr int LDS_BYTES = 144 * 1024;

constexpr size_t WS_WT_ATT = 0;
constexpr size_t WS_WT_SSM = WS_WT_ATT + (size_t)NATT * DM * 2;
constexpr size_t WS_WOA    = WS_WT_SSM + (size_t)LDB_S * DM * 2;
constexpr size_t WS_WOS    = WS_WOA + (size_t)DM * DM * 2;
constexpr size_t WS_WO     = WS_WOS + (size_t)DM * 2048 * 2;
constexpr size_t WS_U      = WS_WO + (size_t)DM * DM * 2;
constexpr size_t WS_DT     = WS_U + (size_t)NROW * DM * 2;
constexpr size_t WS_SSQ    = WS_DT + (size_t)NROW * 32 * 4;
constexpr size_t WS_MKV    = WS_SSQ + (size_t)NROW * 32 * 4;
constexpr size_t WS_MXBC   = WS_MKV + 16 * 512 * 2;
constexpr size_t WS_MDT    = WS_MXBC + 16 * 3072 * 2;
constexpr size_t WS_BUF    = WS_MDT + 16 * 32 * 4;
constexpr size_t WS_BAR    = WS_BUF + (size_t)NROW * LDB_S * 2;
constexpr size_t WS_MCB    = WS_BAR + 3456 * 4;
constexpr size_t WS_END    = WS_MCB + 16 * 1024 * 2;

struct Params {
    const float *x, *meta, *g_pre, *w_in, *conv_w, *conv_b, *dt_bias, *a_log, *d_skip, *sinks, *g_ssm, *w_oa, *w_os, *w_o, *g_post;
    float* out; unsigned char* ws; int ph_lo, ph_hi;
};

typedef __bf16 bf16v2 __attribute__((ext_vector_type(2)));
typedef float f32v2 __attribute__((ext_vector_type(2)));
__device__ __forceinline__ unsigned pk2(float lo, float hi) { const f32v2 v = {lo, hi}; const bf16v2 b = __builtin_convertvector(v, bf16v2); return __builtin_bit_cast(unsigned, b); }
__device__ __forceinline__ float lo_f(unsigned w) { return __uint_as_float(w << 16); }
__device__ __forceinline__ float hi_f(unsigned w) { return __uint_as_float(w & 0xffff0000u); }
__device__ __forceinline__ float sigm(float x) { return __builtin_amdgcn_rcpf(1.f + __expf(-x)); }
__device__ __forceinline__ float silu(float x) { return x * __builtin_amdgcn_rcpf(1.f + __expf(-x)); }
__device__ __forceinline__ float softplus(float x) { const float e = __expf(-fabsf(x)); const float ser = e * (1.f - e * (0.5f - e * 0.333333343f)), lg = __logf(1.f + e); return fmaxf(x, 0.f) + (e < 0.03f ? ser : lg); }
template <int CTRL, int ROWMASK> __device__ __forceinline__ float dpp_add(float v) { return v + __builtin_bit_cast(float, __builtin_amdgcn_update_dpp(0, __builtin_bit_cast(int, v), CTRL, ROWMASK, 0xf, true)); }
__device__ __forceinline__ float wave_scan(float v) {
    v = dpp_add<0x111, 0xf>(v); v = dpp_add<0x112, 0xf>(v); v = dpp_add<0x114, 0xf>(v); v = dpp_add<0x118, 0xf>(v);
    v = dpp_add<0x142, 0xa>(v); v = dpp_add<0x143, 0xc>(v); return v;
}
__device__ __forceinline__ float wave_sum(float v) { v = wave_scan(v); return __builtin_bit_cast(float, __builtin_amdgcn_readlane(__builtin_bit_cast(int, v), 63)); }
__device__ __forceinline__ bf16x8 as_bf16x8(u32x4 v) { union { u32x4 u; bf16x8 b; } c; c.u = v; return c.b; }


#define XB_TMO      128
#define XB_XCNT(j)  (256  + 64 * (j))
#define XB_XSUB(j)  (1280 + 64 * (j))
#define XB_XGEN(j)  (2304 + 64 * (j))
#define XB_TOP      3328
#define XB_TOPGEN   3392
#define XCD_BAR_WORDS 3456
#define XB_SPIN_CAP (1u << 18)
__device__ __forceinline__ unsigned xb_ld(unsigned* p)              { return __hip_atomic_load(p, __ATOMIC_RELAXED, __HIP_MEMORY_SCOPE_AGENT); }
__device__ __forceinline__ unsigned xb_add(unsigned* p, unsigned v) { return __hip_atomic_fetch_add(p, v, __ATOMIC_RELAXED, __HIP_MEMORY_SCOPE_AGENT); }
__device__ __forceinline__ unsigned xb_xcc_id() { return (unsigned)__builtin_amdgcn_s_getreg((3 << 11) | 20) & 0xFu; }
#define XB_SPIN(cond, bar) do { unsigned _sp = 0; while (cond) { __builtin_amdgcn_s_sleep(1); \
    if ((++_sp & 255u) == 0u) { if (xb_ld(&(bar)[XB_TMO])) break; if (_sp > XB_SPIN_CAP) { atomicAdd(&(bar)[XB_TMO], 1u); break; } } } } while (0)
struct XcdBarrier { unsigned* bar; unsigned x; volatile LAS unsigned* st; };
__device__ __forceinline__ XcdBarrier xcd_barrier_post(unsigned* bar, volatile LAS unsigned* st) {
    XcdBarrier b; b.bar = bar; b.x = xb_xcc_id(); b.st = st;
    if (threadIdx.x == 0) (void)xb_add(&bar[XB_XCNT(b.x)], 1u);
    return b;
}
__device__ __forceinline__ void xcd_barrier_complete(unsigned* bar, unsigned x, unsigned& nloc, unsigned& nx) {
    const unsigned G = gridDim.x * gridDim.y * gridDim.z;
    unsigned sum, cnt, mine, sp = 0u;
    for (;;) {
        sum = 0u; cnt = 0u; mine = 0u;
#pragma unroll
        for (unsigned j = 0; j < 16; ++j) { const unsigned c = xb_ld(&bar[XB_XCNT(j)]); sum += c; cnt += (c > 0u) ? 1u : 0u; mine = (j == x) ? c : mine; }
        if (sum == G) break;
        __builtin_amdgcn_s_sleep(1);
        if ((++sp & 255u) == 0u) { if (xb_ld(&bar[XB_TMO])) break; if (sp > XB_SPIN_CAP) { atomicAdd(&bar[XB_TMO], 1u); break; } }
    }
    nloc = mine > 0u ? mine : 1u; nx = cnt > 0u ? cnt : 1u;
}
__device__ __forceinline__ void xcd_barrier(const XcdBarrier& b) {
    asm volatile("s_waitcnt vmcnt(0)" ::: "memory");
    __syncthreads();
    if (threadIdx.x == 0) {
        unsigned* bar = b.bar;
        __builtin_amdgcn_s_waitcnt(0);
        unsigned nloc = b.st[0], nx = b.st[1];
        if (nloc == 0u) { xcd_barrier_complete(bar, b.x, nloc, nx); b.st[0] = nloc; b.st[1] = nx; }
        const unsigned old = xb_add(&bar[XB_XSUB(b.x)], 1u);
        const unsigned gen = old / nloc;
        if (old + 1u == (gen + 1u) * nloc) {
            __builtin_amdgcn_fence(__ATOMIC_RELEASE, "agent");
            asm volatile("s_waitcnt vmcnt(0)" ::: "memory");
            const unsigned og = xb_add(&bar[XB_TOP], 1u);
            const unsigned tg = og / nx;
            if (og + 1u == (tg + 1u) * nx) xb_add(&bar[XB_TOPGEN], 1u);
            else XB_SPIN(xb_ld(&bar[XB_TOPGEN]) == tg, bar);
            __builtin_amdgcn_fence(__ATOMIC_ACQUIRE, "agent");
            xb_add(&bar[XB_XGEN(b.x)], 1u);
            asm volatile("s_waitcnt vmcnt(0)" ::: "memory");
        } else {
            XB_SPIN(xb_ld(&bar[XB_XGEN(b.x)]) == gen, bar);
            __builtin_amdgcn_fence(__ATOMIC_ACQUIRE, "agent");
            asm volatile("s_waitcnt vmcnt(0)" ::: "memory");
        }
    }
    __syncthreads();
}

struct EpiStore {
    static constexpr bool PERM = true, AFTER_DRAIN = false;
    bf16_t* O; int ldc;
    __device__ __forceinline__ void operator()(const f32x4 (&acc)[2][2][4][2], const pg8::Unit& u, int wr, int wc, int fr, int fq) const {
        const int row0 = u.pm * 256 + wr * 64 + fr, col0 = u.pn * 256 + wc * 32 + 8 * fq;
#pragma unroll
        for (int ai = 0; ai < 2; ++ai)
#pragma unroll
            for (int m = 0; m < 4; ++m) { bf16_t* rowp = O + (size_t)(row0 + ai * 128 + m * 16) * ldc + col0;
#pragma unroll
                for (int bj = 0; bj < 2; ++bj) { const f32x4 v0 = acc[ai][bj][m][0], v1 = acc[ai][bj][m][1];
                    u32x4 w; w.x = pk2(v0[0], v0[1]); w.y = pk2(v0[2], v0[3]); w.z = pk2(v1[0], v1[1]); w.w = pk2(v1[2], v1[3]);
                    *(u32x4*)(rowp + bj * 128) = w; } }
    }
};
struct EpiAtt {
    static constexpr bool PERM = true, AFTER_DRAIN = false;
    bf16_t* O; float* dt; const float* dt_bias;
    __device__ __forceinline__ void operator()(const f32x4 (&acc)[2][2][4][2], const pg8::Unit& u, int wr, int wc, int fr, int fq) const {
        const int row0 = u.pm * 256 + wr * 64 + fr;
        if (u.pn < 14) { EpiStore e{O, LDA_A}; e(acc, u, wr, wc, fr, fq); }
        else if (wc == 0) {
#pragma unroll
            for (int n = 0; n < 2; ++n) { const int col = 8 * fq + 4 * n; const f32x4 bv = *(const f32x4*)(dt_bias + col);
#pragma unroll
                for (int ai = 0; ai < 2; ++ai)
#pragma unroll
                    for (int m = 0; m < 4; ++m) { const f32x4 v = acc[ai][0][m][n] + bv; f32x4 o; o[0] = softplus(v[0]); o[1] = softplus(v[1]); o[2] = softplus(v[2]); o[3] = softplus(v[3]);
                        *(f32x4*)(dt + (size_t)(row0 + ai * 128 + m * 16) * 32 + col) = o; } }
        }
    }
};
struct EpiYatt {
    static constexpr bool PERM = true, AFTER_DRAIN = false;
    const bf16_t* bufA; bf16_t* m1;
    __device__ __forceinline__ void operator()(const f32x4 (&acc)[2][2][4][2], const pg8::Unit& u, int wr, int wc, int fr, int fq) const {
        const int row0 = u.pm * 256 + wr * 64 + fr, col0 = u.pn * 256 + wc * 32 + 8 * fq;
#pragma unroll
        for (int ai = 0; ai < 2; ++ai)
#pragma unroll
            for (int m = 0; m < 4; ++m) { const size_t row = (size_t)(row0 + ai * 128 + m * 16);
#pragma unroll
                for (int bj = 0; bj < 2; ++bj) { const int col = col0 + bj * 128; const f32x4 v0 = acc[ai][bj][m][0], v1 = acc[ai][bj][m][1];
                    const u32x4 gt = *(const u32x4*)(bufA + row * LDA_A + 2560 + col);
                    u32x4 w; w.x = pk2(v0[0] * sigm(lo_f(gt.x)), v0[1] * sigm(hi_f(gt.x))); w.y = pk2(v0[2] * sigm(lo_f(gt.y)), v0[3] * sigm(hi_f(gt.y)));
                    w.z = pk2(v1[0] * sigm(lo_f(gt.z)), v1[1] * sigm(hi_f(gt.z))); w.w = pk2(v1[2] * sigm(lo_f(gt.w)), v1[3] * sigm(hi_f(gt.w)));
                    *(u32x4*)(m1 + row * DM + col) = w; } }
    }
};
struct EpiYssm {
    static constexpr bool PERM = true, AFTER_DRAIN = false;
    const bf16_t* bufB; const bf16_t* m1; bf16_t* mg;
    __device__ __forceinline__ void operator()(const f32x4 (&acc)[2][2][4][2], const pg8::Unit& u, int wr, int wc, int fr, int fq) const {
        const int row0 = u.pm * 256 + wr * 64 + fr, col0 = u.pn * 256 + wc * 32 + 8 * fq;
#pragma unroll
        for (int ai = 0; ai < 2; ++ai)
#pragma unroll
            for (int m = 0; m < 4; ++m) { const size_t row = (size_t)(row0 + ai * 128 + m * 16);
#pragma unroll
                for (int bj = 0; bj < 2; ++bj) { const int col = col0 + bj * 128; const f32x4 v0 = acc[ai][bj][m][0], v1 = acc[ai][bj][m][1];
                    const u32x4 gt = *(const u32x4*)(bufB + row * LDB_S + 5120 + col); const u32x4 mm = *(const u32x4*)(m1 + row * DM + col);
                    u32x4 w; w.x = pk2(lo_f(mm.x) + v0[0] * sigm(lo_f(gt.x)), hi_f(mm.x) + v0[1] * sigm(hi_f(gt.x))); w.y = pk2(lo_f(mm.y) + v0[2] * sigm(lo_f(gt.y)), hi_f(mm.y) + v0[3] * sigm(hi_f(gt.y)));
                    w.z = pk2(lo_f(mm.z) + v1[0] * sigm(lo_f(gt.z)), hi_f(mm.z) + v1[1] * sigm(hi_f(gt.z))); w.w = pk2(lo_f(mm.w) + v1[2] * sigm(lo_f(gt.w)), hi_f(mm.w) + v1[3] * sigm(hi_f(gt.w)));
                    *(u32x4*)(mg + row * DM + col) = w; } }
    }
};
struct EpiF32 {
    static constexpr bool PERM = false, AFTER_DRAIN = false;
    float* C; int ldc;
    __device__ __forceinline__ void operator()(const f32x4 (&acc)[2][2][4][2], const pg8::Unit& u, int wr, int wc, int fr, int fq) const {
        const int row0 = u.pm * 256 + wr * 64 + fr, col0 = u.pn * 256 + wc * 32 + 4 * fq;
#pragma unroll
        for (int ai = 0; ai < 2; ++ai)
#pragma unroll
            for (int m = 0; m < 4; ++m) { float* rowp = C + (size_t)(row0 + ai * 128 + m * 16) * ldc + col0;
#pragma unroll
                for (int bj = 0; bj < 2; ++bj)
#pragma unroll
                    for (int n = 0; n < 2; ++n) *(f32x4*)(rowp + bj * 128 + n * 16) = acc[ai][bj][m][n]; }
    }
};

__device__ __forceinline__ void prep_phase(const Params& p, LAS unsigned char* lds) {
    const int tid = threadIdx.x, lane = tid & 63, wave = __builtin_amdgcn_readfirstlane(tid >> 6), G = gridDim.x;
    unsigned char* ws = p.ws;
    for (int ci = blockIdx.x; ci < 226; ci += G) {
        LAS float* um = (LAS float*)lds;
        LAS float* Wl = (LAS float*)(lds + 65536);
        LAS float* red = (LAS float*)(lds + 131072);
        const int c0 = ci < 32 ? 1024 + 16 * ci : (ci < 224 ? 4608 + 16 * (ci - 32) : 7680 + 16 * (ci - 224));
        __syncthreads();
#pragma unroll
        for (int rr = 0; rr < 2; ++rr) { const int r = 2 * wave + rr; f32x4 v[4]; float s = 0.f;
#pragma unroll
            for (int i = 0; i < 4; ++i) { v[i] = *(const f32x4*)(p.meta + r * DM + 4 * lane + 256 * i); s += v[i][0] * v[i][0] + v[i][1] * v[i][1] + v[i][2] * v[i][2] + v[i][3] * v[i][3]; }
            const float rstd = rsqrtf(wave_sum(s) * (1.f / DM) + EPS);
#pragma unroll
            for (int i = 0; i < 4; ++i) { const f32x4 gg = *(const f32x4*)(p.g_pre + 4 * lane + 256 * i); *(LAS f32x4*)(um + r * DM + 4 * lane + 256 * i) = v[i] * rstd * gg; } }
#pragma unroll
        for (int i = 0; i < 8; ++i) { const int idx = tid + 512 * i, k = idx >> 2, c4 = idx & 3; *(LAS f32x4*)(Wl + k * 16 + 4 * c4) = *(const f32x4*)(p.w_in + (size_t)k * NIN + c0 + 4 * c4); }
        __syncthreads();
        { const int c = tid & 15, r = (tid >> 4) & 15, kh = tid >> 8; float s = 0.f;
          for (int k = 512 * kh; k < 512 * kh + 512; k += 4) { const f32x4 uu = *(const LAS f32x4*)(um + r * DM + k);
              s += uu[0] * Wl[(k + 0) * 16 + c] + uu[1] * Wl[(k + 1) * 16 + c] + uu[2] * Wl[(k + 2) * 16 + c] + uu[3] * Wl[(k + 3) * 16 + c]; }
          red[kh * 256 + (tid & 255)] = s; }
        __syncthreads();
        if (tid < 256) { const float s = red[tid] + red[256 + tid]; const int c = tid & 15, r = tid >> 4;
            if (ci < 32) ((bf16_t*)(ws + WS_MKV))[r * 512 + 16 * ci + c] = (bf16_t)(pk2(s, 0.f) & 0xffffu);
            else if (ci < 224) ((bf16_t*)(ws + WS_MXBC))[r * 3072 + 16 * (ci - 32) + c] = (bf16_t)(pk2(s, 0.f) & 0xffffu);
            else { const int j = 16 * (ci - 224) + c; ((float*)(ws + WS_MDT))[r * 32 + j] = softplus(s + p.dt_bias[j]); } }
        __syncthreads();
    }
    {   constexpr int T_ATT = (NATT / 64) * 16, T_SSM = (LDB_S / 64) * 16, T_OA = 256, T_OS = 512, T_O = 256, T_ALL = T_ATT + T_SSM + T_OA + T_OS + T_O, NT = 4;
        const int kk = tid >> 4, c4 = tid & 15;
        for (int it0 = blockIdx.x; it0 < T_ALL; it0 += NT * G) {
            f32x4 v[NT][2]; float sc[NT][2]; bf16_t* dptr[NT]; bool live[NT];
#pragma unroll
            for (int q = 0; q < NT; ++q) { const int it = it0 + q * G; live[q] = it < T_ALL;
                const float* src = p.w_o; int ld = DM, K = DM, n0 = 0, k0 = 0, scol = 0, nvalid = 64; bf16_t* dst = (bf16_t*)(ws + WS_WO); const float* kscale = nullptr; int r = live[q] ? it : 0;
                if (r < T_ATT) { src = p.w_in; ld = NIN; K = DM; n0 = 64 * (r >> 4); k0 = 64 * (r & 15); dst = (bf16_t*)(ws + WS_WT_ATT);
                    if (n0 < 2560) scol = n0; else if (n0 < 3584) scol = 7712 + (n0 - 2560); else if (n0 == 3584) { scol = 7680; nvalid = 32; } else nvalid = 0; }
                else if ((r -= T_ATT) < T_SSM) { src = p.w_in; ld = NIN; K = DM; n0 = 64 * (r >> 4); k0 = 64 * (r & 15); dst = (bf16_t*)(ws + WS_WT_SSM);
                    if (n0 < 2048) scol = 2560 + n0; else if (n0 < 5120) scol = 4608 + (n0 - 2048); else scol = 8736 + (n0 - 5120); }
                else if ((r -= T_SSM) < T_OA) { src = p.w_oa; ld = DM; K = DM; n0 = 64 * (r >> 4); k0 = 64 * (r & 15); dst = (bf16_t*)(ws + WS_WOA); scol = n0; }
                else if ((r -= T_OA) < T_OS) { src = p.w_os; ld = DM; K = 2048; n0 = 64 * (r >> 5); k0 = 64 * (r & 31); dst = (bf16_t*)(ws + WS_WOS); scol = n0; kscale = p.g_ssm; }
                else { r -= T_OS; src = p.w_o; ld = DM; K = DM; n0 = 64 * (r >> 4); k0 = 64 * (r & 15); dst = (bf16_t*)(ws + WS_WO); scol = n0; }
                const bool ok = 4 * c4 < nvalid; const int sc_ = ok ? scol : 0;
#pragma unroll
                for (int rep = 0; rep < 2; ++rep) { const int k = k0 + kk + 32 * rep;
                    v[q][rep] = *(const f32x4*)(src + (size_t)k * ld + sc_ + 4 * c4);
                    sc[q][rep] = !ok ? 0.f : (kscale ? kscale[k] : 1.f); }
                dptr[q] = dst + (size_t)(n0 + (tid >> 3)) * K + k0 + 8 * (tid & 7); }
#pragma unroll
            for (int q = 0; q < NT; ++q) { LAS float* tile = (LAS float*)lds + q * (64 * 65);
#pragma unroll
                for (int rep = 0; rep < 2; ++rep) { const int k = kk + 32 * rep; const f32x4 t = v[q][rep] * sc[q][rep];
                    tile[k * 65 + 4 * c4 + 0] = t[0]; tile[k * 65 + 4 * c4 + 1] = t[1]; tile[k * 65 + 4 * c4 + 2] = t[2]; tile[k * 65 + 4 * c4 + 3] = t[3]; } }
            __syncthreads();
#pragma unroll
            for (int q = 0; q < NT; ++q) { const int n = tid >> 3, k8 = tid & 7; const LAS float* t = (const LAS float*)lds + q * (64 * 65) + (8 * k8) * 65 + n;
                u32x4 o; o.x = pk2(t[0], t[65]); o.y = pk2(t[2 * 65], t[3 * 65]); o.z = pk2(t[4 * 65], t[5 * 65]); o.w = pk2(t[6 * 65], t[7 * 65]);
                if (live[q]) *(u32x4*)dptr[q] = o; }
            __syncthreads();
        }
    }
    {   bf16_t* U = (bf16_t*)(ws + WS_U);
        f32x4 gg[4];
#pragma unroll
        for (int i = 0; i < 4; ++i) gg[i] = *(const f32x4*)(p.g_pre + 4 * lane + 256 * i);
        for (int row0 = blockIdx.x * 8 + wave; row0 < NROW; row0 += G * 32) { f32x4 v[4][4];
#pragma unroll
            for (int r = 0; r < 4; ++r) { const int row = row0 + r * G * 8; const int rr = row < NROW ? row : row0;
#pragma unroll
                for (int i = 0; i < 4; ++i) v[r][i] = *(const f32x4*)(p.x + (size_t)rr * DM + 4 * lane + 256 * i); }
#pragma unroll
            for (int r = 0; r < 4; ++r) { const int row = row0 + r * G * 8; float s = 0.f;
#pragma unroll
                for (int i = 0; i < 4; ++i) s += v[r][i][0] * v[r][i][0] + v[r][i][1] * v[r][i][1] + v[r][i][2] * v[r][i][2] + v[r][i][3] * v[r][i][3];
                const float rstd = rsqrtf(wave_sum(s) * (1.f / DM) + EPS);
                if (row < NROW) {
#pragma unroll
                    for (int i = 0; i < 4; ++i) { const f32x4 o = v[r][i] * rstd * gg[i];
                        u32x2 w; w.x = pk2(o[0], o[1]); w.y = pk2(o[2], o[3]); *(u32x2*)(U + (size_t)row * DM + 4 * lane + 256 * i) = w; } } } }
    }
}

__device__ __forceinline__ void attn_phase(const Params& p, LAS unsigned char* lds, bool dry = false) {
    const int tid = threadIdx.x, lane = tid & 63, wave = __builtin_amdgcn_readfirstlane(tid >> 6), fr = lane & 15, fq = lane >> 4;
    constexpr int KP = 72, VP = 296;
    LAS bf16_t* Ks = (LAS bf16_t*)lds;
    LAS bf16_t* Vt = (LAS bf16_t*)(lds + 288 * KP * 2);
    bf16_t* bufA = (bf16_t*)(p.ws + WS_BUF); const bf16_t* mkv = (const bf16_t*)(p.ws + WS_MKV);
    u32x4 kv[5], vv[5];
#define ATT_LOAD_KV(itm) do { const int ib_ = (itm) & 7, ig_ = ((itm) >> 3) & 3, ij_ = (itm) >> 5; \
        _Pragma("unroll") for (int it = 0; it < 5; ++it) { const int idx = tid + 512 * it, ic = idx < 288 * 8 ? idx : 0, oc = ic / 288, s = ic - 288 * oc, tk = 128 * ij_ - 160 + s; \
            const bf16_t* kp = (s < 16) ? mkv + s * 512 + 64 * ig_ + 8 * oc : bufA + (size_t)(ib_ * TSEQ + (tk > 0 ? tk : 0)) * LDA_A + 1024 + 64 * ig_ + 8 * oc; \
            kv[it] = *(const u32x4*)kp; vv[it] = *(const u32x4*)(kp + 256); } } while (0)
    if ((int)blockIdx.x < 512) ATT_LOAD_KV((int)blockIdx.x);
    for (int item = blockIdx.x; item < 512; item += gridDim.x) {
        const int b = item & 7, g = (item >> 3) & 3, j = item >> 5;
        __syncthreads();
        {
#pragma unroll
            for (int it = 0; it < 5; ++it) { const int idx = tid + 512 * it;
                if (idx < 288 * 8) { const int oc = idx / 288, s = idx - 288 * oc, tk = 128 * j - 160 + s; const bool keep = (s < 16) || (s >= 32 && tk >= 0);
                    u32x4 k_ = kv[it], v_ = vv[it]; if (!keep) { k_ = (u32x4){0u, 0u, 0u, 0u}; v_ = k_; }
                    *(LAS u32x4*)(Ks + s * KP + 8 * oc) = k_;
                    LAS bf16_t* vp = Vt + (8 * oc) * VP + s;
                    vp[0 * VP] = (bf16_t)(v_.x & 0xffffu); vp[1 * VP] = (bf16_t)(v_.x >> 16); vp[2 * VP] = (bf16_t)(v_.y & 0xffffu); vp[3 * VP] = (bf16_t)(v_.y >> 16);
                    vp[4 * VP] = (bf16_t)(v_.z & 0xffffu); vp[5 * VP] = (bf16_t)(v_.z >> 16); vp[6 * VP] = (bf16_t)(v_.w & 0xffffu); vp[7 * VP] = (bf16_t)(v_.w >> 16); } }
        }
        __syncthreads();
        const int hq = wave >> 1, half = wave & 1, H = 4 * g + hq;
        const float slope = exp2f(-0.5f * (float)(H + 1)), sink = p.sinks[H];
        bf16x8 qn[2]; u32x2 zn[4];
        { const bf16_t* rp0 = bufA + (size_t)(b * TSEQ + 128 * j + 64 * half + fr) * LDA_A + 64 * H;
          qn[0] = *(const bf16x8*)(rp0 + 8 * fq); qn[1] = *(const bf16x8*)(rp0 + 32 + 8 * fq);
#pragma unroll
          for (int dt = 0; dt < 4; ++dt) zn[dt] = *(const u32x2*)(rp0 + 1536 + 16 * dt + 4 * fq); }
        { const int nitem = item + (int)gridDim.x; if (nitem < 512) ATT_LOAD_KV(nitem); }
#pragma unroll 1
        for (int qt = 0; qt < 4; ++qt) {
            const int tq = 128 * j + 64 * half + 16 * qt + fr;
            bf16_t* rowp = bufA + (size_t)(b * TSEQ + tq) * LDA_A;
            bf16x8 qf[2]; u32x2 zc[4];
            qf[0] = qn[0]; qf[1] = qn[1];
#pragma unroll
            for (int dt = 0; dt < 4; ++dt) zc[dt] = zn[dt];
            if (qt < 3) { const bf16_t* rp1 = rowp + (size_t)16 * LDA_A + 64 * H;
                qn[0] = *(const bf16x8*)(rp1 + 8 * fq); qn[1] = *(const bf16x8*)(rp1 + 32 + 8 * fq);
#pragma unroll
                for (int dt = 0; dt < 4; ++dt) zn[dt] = *(const u32x2*)(rp1 + 1536 + 16 * dt + 4 * fq); }
            const float g4 = 8.f * slope * (float)(4 * fq);
            f32x4 sa[18];
#pragma unroll
            for (int st = 0; st < 18; ++st) { f32x4 a = {0.f, 0.f, 0.f, 0.f};
                if (st >= 2) a = (f32x4){g4, g4, g4, g4};
                if (st != 1) {
#pragma unroll
                    for (int ks = 0; ks < 2; ++ks) { const bf16x8 kf = *(const LAS bf16x8*)(Ks + (16 * st + fr) * KP + 32 * ks + 8 * fq); a = __builtin_amdgcn_mfma_f32_16x16x32_bf16(kf, qf[ks], a, 0, 0, 0); } }
                sa[st] = a; if ((st & 7) == 7) __builtin_amdgcn_sched_barrier(0); }
            const float r8 = 8.f * slope, sc2 = 0.125f * 1.44269504f;
            const int R1 = tq - (128 * j - 160) - 4 * fq;
            const unsigned hi = (j == 0) ? (unsigned)tq : 127u;
            const float c0 = -r8 * (float)(R1 + 4 * fq);
            float mx = 8.f * sink - c0;
#pragma unroll
            for (int st = 0; st < 18; ++st)
#pragma unroll
                for (int jj = 0; jj < 4; ++jj) { float x;
                    if (st == 0) x = sa[0][jj] - c0;
                    else if (st == 1) x = -INFINITY;
                    else { const unsigned rel = (unsigned)(R1 - (16 * st + jj)); x = fmaf((float)(16 * st + jj), r8, sa[st][jj]); x = (rel <= hi) ? x : -INFINITY; }
                    sa[st][jj] = x; mx = fmaxf(mx, x); }
            mx = fmaxf(mx, __shfl_xor(mx, 16)); mx = fmaxf(mx, __shfl_xor(mx, 32));
            const float nm = -mx * sc2;
            float sum = 0.f;
#pragma unroll
            for (int st = 0; st < 18; ++st)
#pragma unroll
                for (int jj = 0; jj < 4; ++jj) { const float e = __builtin_amdgcn_exp2f(fmaf(sa[st][jj], sc2, nm)); sa[st][jj] = e; sum += e; }
            sum += __shfl_xor(sum, 16); sum += __shfl_xor(sum, 32); sum += __builtin_amdgcn_exp2f(fmaf(8.f * sink - c0, sc2, nm));
            const float inv = 1.f / sum;
            f32x4 oa[4];
#pragma unroll
            for (int dt = 0; dt < 4; ++dt) oa[dt] = (f32x4){0.f, 0.f, 0.f, 0.f};
#pragma unroll
            for (int u = 0; u < 9; ++u) { u32x4 pw; pw.x = pk2(sa[2 * u][0], sa[2 * u][1]); pw.y = pk2(sa[2 * u][2], sa[2 * u][3]); pw.z = pk2(sa[2 * u + 1][0], sa[2 * u + 1][1]); pw.w = pk2(sa[2 * u + 1][2], sa[2 * u + 1][3]);
                const bf16x8 pf = as_bf16x8(pw);
#pragma unroll
                for (int dt = 0; dt < 4; ++dt) { const LAS bf16_t* vr = Vt + (16 * dt + fr) * VP + 32 * u + 4 * fq; const u32x2 v0 = *(const LAS u32x2*)vr, v1 = *(const LAS u32x2*)(vr + 16);
                    u32x4 vw; vw.x = v0.x; vw.y = v0.y; vw.z = v1.x; vw.w = v1.y;
                    oa[dt] = __builtin_amdgcn_mfma_f32_16x16x32_bf16(as_bf16x8(vw), pf, oa[dt], 0, 0, 0); }
                if ((u & 3) == 3) __builtin_amdgcn_sched_barrier(0); }
#pragma unroll
            for (int dt = 0; dt < 4; ++dt) { const int col = 64 * H + 16 * dt + 4 * fq; const u32x2 zz = zc[dt];
                u32x2 w; w.x = pk2(oa[dt][0] * inv * silu(lo_f(zz.x)), oa[dt][1] * inv * silu(hi_f(zz.x))); w.y = pk2(oa[dt][2] * inv * silu(lo_f(zz.y)), oa[dt][3] * inv * silu(hi_f(zz.y)));
                if (!dry) *(u32x2*)(rowp + col) = w; }
        }
    }
}

__device__ __forceinline__ u32x4 xbc_row(const bf16_t* bufB, const bf16_t* mxbc, int b, int pos, int xc) {
    const int pm = pos < 0 ? 0 : pos;
    const bf16_t* ptr = (pos < 16) ? mxbc + pm * 3072 + xc : bufB + (size_t)(b * TSEQ + pos - 16) * LDB_S + 2048 + xc;
    return *(const u32x4*)ptr;
}
template <int NR> __device__ __forceinline__ void raw_load(const bf16_t* bufB, const bf16_t* mxbc, int b, int pos0, int xc, u32x4 (&rw)[NR + 3]) {
#pragma unroll
    for (int i = 0; i < NR + 3; ++i) rw[i] = xbc_row(bufB, mxbc, b, pos0 - 3 + i, xc);
}
template <int NR, int CS = 320> __device__ __forceinline__ void conv_block(const LAS float* cwl, const u32x4 (&rw)[NR + 3], int pos0, int lc, float (&out)[NR][8]) {
    { const f32x4 a = *(const LAS f32x4*)(cwl + 4 * CS + lc), c = *(const LAS f32x4*)(cwl + 4 * CS + lc + 4);
#pragma unroll
      for (int r = 0; r < NR; ++r) { out[r][0] = a[0]; out[r][1] = a[1]; out[r][2] = a[2]; out[r][3] = a[3]; out[r][4] = c[0]; out[r][5] = c[1]; out[r][6] = c[2]; out[r][7] = c[3]; } }
#pragma unroll
    for (int k = 0; k < 4; ++k) { const f32x4 wa = *(const LAS f32x4*)(cwl + k * CS + lc), wb = *(const LAS f32x4*)(cwl + k * CS + lc + 4);
#pragma unroll
        for (int r = 0; r < NR; ++r) { u32x4 r_ = rw[r + k]; if (pos0 - 3 + r + k < 0) r_ = (u32x4){0u, 0u, 0u, 0u};
            out[r][0] += wa[0] * lo_f(r_.x); out[r][1] += wa[1] * hi_f(r_.x); out[r][2] += wa[2] * lo_f(r_.y); out[r][3] += wa[3] * hi_f(r_.y);
            out[r][4] += wb[0] * lo_f(r_.z); out[r][5] += wb[1] * hi_f(r_.z); out[r][6] += wb[2] * lo_f(r_.w); out[r][7] += wb[3] * hi_f(r_.w); } }
#pragma unroll
    for (int r = 0; r < NR; ++r) { const float lf = (pos0 + r) >= 0 ? 1.f : 0.f;
#pragma unroll
        for (int ch = 0; ch < 8; ++ch) out[r][ch] = silu(out[r][ch]) * lf; }
}

__device__ __forceinline__ void convbc_phase(const Params& p, LAS unsigned char* lds) {
    const int tid = threadIdx.x, lane = tid & 63, w = __builtin_amdgcn_readfirstlane(tid >> 6), fr = lane & 15, fq = lane >> 4;
    constexpr int LP = 136;
    LAS bf16_t* Bs = (LAS bf16_t*)lds; LAS bf16_t* Cs = (LAS bf16_t*)(lds + 34816);
    LAS float* cw2 = (LAS float*)(lds + 69632);
    const bf16_t* bufB = (const bf16_t*)(p.ws + WS_BUF); const bf16_t* mxbc = (const bf16_t*)(p.ws + WS_MXBC);
    bf16_t* CB = (bf16_t*)(p.ws + WS_U); bf16_t* MCB = (bf16_t*)(p.ws + WS_MCB); float* MT = (float*)((char*)p.out + (size_t)NROW * DM * 2);
    __syncthreads();
    for (int i = tid; i < 5 * 1024; i += 512) { const int k = i >> 10, ch = i & 1023; cw2[i] = (k < 4) ? p.conv_w[k * 3072 + 2048 + ch] : p.conv_b[2048 + ch]; }
    __syncthreads();
    for (int it = blockIdx.x; it < 512; it += gridDim.x) {
        const int b = it & 7, g = (it >> 3) & 3, ci = it >> 5;
        const int r4 = tid >> 4, oc = tid & 15, pos0 = 16 + 128 * ci + 4 * r4, colB = 128 * g + 8 * oc, colC = 512 + colB;
        u32x4 rb[7], rc[7];
        raw_load<4>(bufB, mxbc, b, pos0, 2048 + colB, rb); raw_load<4>(bufB, mxbc, b, pos0, 2048 + colC, rc);
        bf16_t* dst = CB + (size_t)(b * TSEQ + pos0 - 16) * 1024;
        { float o[4][8]; conv_block<4, 1024>(cw2, rb, pos0, colB, o);
#pragma unroll
          for (int r = 0; r < 4; ++r) { u32x4 v; v.x = pk2(o[r][0], o[r][1]); v.y = pk2(o[r][2], o[r][3]); v.z = pk2(o[r][4], o[r][5]); v.w = pk2(o[r][6], o[r][7]);
              *(u32x4*)(dst + r * 1024 + colB) = v; *(LAS u32x4*)(Bs + (4 * r4 + r) * LP + 8 * oc) = v; } }
        { float o[4][8]; conv_block<4, 1024>(cw2, rc, pos0, colC, o);
#pragma unroll
          for (int r = 0; r < 4; ++r) { u32x4 v; v.x = pk2(o[r][0], o[r][1]); v.y = pk2(o[r][2], o[r][3]); v.z = pk2(o[r][4], o[r][5]); v.w = pk2(o[r][6], o[r][7]);
              *(u32x4*)(dst + r * 1024 + colC) = v; *(LAS u32x4*)(Cs + (4 * r4 + r) * LP + 8 * oc) = v; } }
        __syncthreads();
        { bf16x8 cf[4];
#pragma unroll
          for (int kn = 0; kn < 4; ++kn) cf[kn] = *(const LAS bf16x8*)(Cs + (16 * w + fr) * LP + 32 * kn + 8 * fq);
          float* mo = MT + ((size_t)(it * 8 + w) * 8) * 256 + lane * 4;
#pragma unroll
          for (int st = 0; st < 8; ++st) if (st <= w) { f32x4 m = {0.f, 0.f, 0.f, 0.f};
#pragma unroll
              for (int kn = 0; kn < 4; ++kn) { const bf16x8 a = *(const LAS bf16x8*)(Bs + (16 * st + fr) * LP + 32 * kn + 8 * fq); m = __builtin_amdgcn_mfma_f32_16x16x32_bf16(a, cf[kn], m, 0, 0, 0); }
              *(f32x4*)(mo + st * 256) = m; } }
        __syncthreads();
    }
    if (blockIdx.x == gridDim.x - 1) {
        const int oc = tid & 127, pos0 = 4 * (tid >> 7); u32x4 rw[7]; float o[4][8];
        raw_load<4>(bufB, mxbc, 0, pos0, 2048 + 8 * oc, rw);
        conv_block<4, 1024>(cw2, rw, pos0, 8 * oc, o);
#pragma unroll
        for (int r = 0; r < 4; ++r) { u32x4 v; v.x = pk2(o[r][0], o[r][1]); v.y = pk2(o[r][2], o[r][3]); v.z = pk2(o[r][4], o[r][5]); v.w = pk2(o[r][6], o[r][7]); *(u32x4*)(MCB + (pos0 + r) * 1024 + 8 * oc) = v; }
    }
}
__device__ __forceinline__ u32x4 cb_row(const bf16_t* CB, const bf16_t* MCB, int b, int pos, int col) {
    const int pm = pos < 0 ? 0 : pos;
    const bf16_t* ptr = (pos < 16) ? MCB + pm * 1024 + col : CB + (size_t)(b * TSEQ + pos - 16) * 1024 + col;
    return *(const u32x4*)ptr;
}
__device__ __forceinline__ void cb_load4(const bf16_t* CB, const bf16_t* MCB, int b, int pos0, int col, u32x4 (&rw)[4]) {
#pragma unroll
    for (int i = 0; i < 4; ++i) rw[i] = cb_row(CB, MCB, b, pos0 + i, col);
}

#define SSD_LBAR() do { asm volatile("s_waitcnt lgkmcnt(0)" ::: "memory"); __builtin_amdgcn_s_barrier(); asm volatile("" ::: "memory"); } while (0)
__device__ __forceinline__ void ssd_phase(const Params& p, LAS unsigned char* lds, bool dry = false) {
    const int tid = threadIdx.x, lane0 = tid & 63, w = __builtin_amdgcn_readfirstlane(tid >> 6);
    constexpr int LP = 136;
    LAS bf16_t* Bs  = (LAS bf16_t*)lds;
    LAS bf16_t* Cs  = (LAS bf16_t*)(lds + 34816);
    LAS bf16_t* BsT = (LAS bf16_t*)(lds + 69632);
    LAS bf16_t* Xt  = (LAS bf16_t*)(lds + 104448);
    LAS bf16_t* Sl  = (LAS bf16_t*)(lds + 121856);
    LAS float* acs = (LAS float*)(lds + 139264); LAS float* dts = acs + 128; LAS float* wl = acs + 256;
    LAS float* cwl = (LAS float*)(lds + 140800);
    bf16_t* bufB = (bf16_t*)(p.ws + WS_BUF); const bf16_t* mxbc = (const bf16_t*)(p.ws + WS_MXBC);
    const bf16_t* CB = (const bf16_t*)(p.ws + WS_U); const bf16_t* MCB = (const bf16_t*)(p.ws + WS_MCB); const float* MT = (const float*)((const char*)p.out + (size_t)NROW * DM * 2);
    const float* dtb = (const float*)(p.ws + WS_DT); const float* mdt = (const float*)(p.ws + WS_MDT); float* ssq = (float*)(p.ws + WS_SSQ);
    const bool lowhalf = w < 4;
    for (int item = blockIdx.x; item < 256; item += gridDim.x) {
        const int b = item & 7, h = item >> 3, g = h >> 3;
        const float A_h = -__expf(p.a_log[h]), D_h = p.d_skip[h];
        f32x4 accS[4];
#pragma unroll
        for (int pt = 0; pt < 4; ++pt) accS[pt] = (f32x4){0.f, 0.f, 0.f, 0.f};
        __syncthreads();
        for (int i = tid; i < 64 * LP / 2; i += 512) ((LAS unsigned*)Sl)[i] = 0u;
        for (int i = tid; i < 5 * 320; i += 512) { const int k = i / 320, lc = i - 320 * k; const int xc = lc < 128 ? 2048 + 128 * g + lc : (lc < 256 ? 2560 + 128 * g + (lc - 128) : 64 * h + (lc - 256));
            cwl[i] = (k < 4) ? p.conv_w[k * 3072 + xc] : p.conv_b[xc]; }
        u32x4 rwA0[4], rwA1[4], rwX[5]; float dn0 = 0.f, dn1 = 0.f;
        if (w == 0) dn1 = (lane0 >= 48) ? mdt[(lane0 - 48) * 32 + h] : 0.f;
#pragma unroll 1
        for (int c = 0; c < 17; ++c) {
            const int pos_base = (c == 0) ? -112 : 16 + 128 * (c - 1);
            int lane = lane0; asm volatile("" : "+v"(lane));
            const int fr = lane & 15, fq = lane >> 4, t2 = lane + 64 * (w & 3);
            const int colA = (lowhalf ? 0 : 512) + 128 * g + 8 * (t2 & 15), r4A = 2 * (t2 >> 4);
            const int tX = lane + 64 * w, xcX = 64 * h + 8 * (tX & 7), r2X = tX >> 3;
            if (c == 0) {
                if (lowhalf) { cb_load4(CB, MCB, b, pos_base + 4 * r4A, colA, rwA0); cb_load4(CB, MCB, b, pos_base + 4 * r4A + 4, colA, rwA1); }
                raw_load<2>(bufB, mxbc, b, pos_base + 2 * r2X, xcX, rwX); }
            f32x4 mt[8];
            if (c > 0) { const float* mp = MT + ((size_t)((b + 8 * (g + 4 * (c - 1))) * 8 + w) * 8) * 256 + lane * 4;
#pragma unroll
                for (int st = 0; st < 8; ++st) if (st <= w) mt[st] = *(const f32x4*)(mp + st * 256); }
            if (w == 0) { const float d0 = dn0, d1 = dn1;
                float a0 = d0 * A_h, a1 = d1 * A_h;
                a0 = wave_scan(a0); a1 = wave_scan(a1);
                a1 += __builtin_bit_cast(float, __builtin_amdgcn_readlane(__builtin_bit_cast(int, a0), 63)); const float alast = __builtin_bit_cast(float, __builtin_amdgcn_readlane(__builtin_bit_cast(int, a1), 63));
                acs[lane] = a0; acs[lane + 64] = a1; dts[lane] = d0; dts[lane + 64] = d1;
                wl[lane] = d0 * __expf(alast - a0); wl[lane + 64] = d1 * __expf(alast - a1); }
            SSD_LBAR();
#ifdef SSD_DRY_SKIPB
            if (!dry)
#endif
            { if (lowhalf) {
#pragma unroll
                  for (int hf = 0; hf < 2; ++hf) { const int r4 = r4A + hf, oc = t2 & 15; float o[4][8];
#pragma unroll
                      for (int r = 0; r < 4; ++r) { u32x4 v = hf == 0 ? rwA0[r] : rwA1[r]; if (pos_base + 4 * r4 + r < 0) v = (u32x4){0u, 0u, 0u, 0u};
                          o[r][0] = lo_f(v.x); o[r][1] = hi_f(v.x); o[r][2] = lo_f(v.y); o[r][3] = hi_f(v.y); o[r][4] = lo_f(v.z); o[r][5] = hi_f(v.z); o[r][6] = lo_f(v.w); o[r][7] = hi_f(v.w); }
                      const f32x4 ww = *(const LAS f32x4*)(wl + 4 * r4);
#pragma unroll
                      for (int ch = 0; ch < 8; ++ch) { u32x2 v; v.x = pk2(o[0][ch] * ww[0], o[1][ch] * ww[1]); v.y = pk2(o[2][ch] * ww[2], o[3][ch] * ww[3]); *(LAS u32x2*)(BsT + (8 * oc + ch) * LP + 8 * ((r4 >> 1) ^ oc) + 4 * (r4 & 1)) = v; } } }
              else if (c > 0) {
#pragma unroll
                  for (int hf = 0; hf < 2; ++hf) { const int r4 = r4A + hf, oc = t2 & 15;
#pragma unroll
                      for (int r = 0; r < 4; ++r) *(LAS u32x4*)(Cs + (4 * r4 + r) * LP + 8 * oc) = hf == 0 ? rwA0[r] : rwA1[r]; } }
            }
            { float o2[2][8]; conv_block<2>(cwl, rwX, pos_base + 2 * r2X, 256 + 8 * (tX & 7), o2); const int oc = tX & 7;
#pragma unroll
              for (int ch = 0; ch < 8; ++ch) *(LAS unsigned*)(Xt + (8 * oc + ch) * LP + 8 * ((r2X >> 2) ^ oc) + 2 * (r2X & 3)) = pk2(o2[0][ch], o2[1][ch]); }
            SSD_LBAR();
            const int l = 16 * w + fr;
            bf16_t* zp = bufB + (size_t)(b * TSEQ + 128 * (c > 0 ? c - 1 : 0) + l) * LDB_S + 64 * h;
            if (c < 16 && w == 0) { const size_t rb = (size_t)(b * TSEQ + 128 * c); dn0 = dtb[(rb + lane) * 32 + h]; dn1 = dtb[(rb + lane + 64) * 32 + h]; }
            if (c < 16) { const int pb = 16 + 128 * c;
                cb_load4(CB, MCB, b, pb + 4 * r4A, colA, rwA0); cb_load4(CB, MCB, b, pb + 4 * r4A + 4, colA, rwA1);
                raw_load<2>(bufB, mxbc, b, pb + 2 * r2X, xcX, rwX); }
            __builtin_amdgcn_sched_barrier(0);
            u32x2 zz[4];
#pragma unroll
            for (int pt = 0; pt < 4; ++pt) zz[pt] = *(const u32x2*)(zp + 16 * pt + 4 * fq);
            { const float elast = __expf(acs[127]);
#pragma unroll
              for (int pt = 0; pt < 4; ++pt) accS[pt] = accS[pt] * elast;
#pragma unroll
              for (int ul = 0; ul < 4; ++ul) { const bf16x8 bfr = *(const LAS bf16x8*)(BsT + (16 * w + fr) * LP + 8 * ((4 * ul + fq) ^ ((2 * w + (fr >> 3)) & 15)));
#pragma unroll
                  for (int pt = 0; pt < 4; ++pt) { const bf16x8 a = *(const LAS bf16x8*)(Xt + (16 * pt + fr) * LP + 8 * ((4 * ul + fq) ^ ((2 * pt + (fr >> 3)) & 7))); accS[pt] = __builtin_amdgcn_mfma_f32_16x16x32_bf16(a, bfr, accS[pt], 0, 0, 0); } } }
            __builtin_amdgcn_sched_barrier(0);
            f32x4 yv[4];
#ifdef SSD_DRY_SKIP
            const bool doC = (c > 0) && !dry;
#else
            const bool doC = (c > 0);
#endif
            if (doC) {
                bf16x8 cf[4];
#pragma unroll
                for (int kn = 0; kn < 4; ++kn) cf[kn] = *(const LAS bf16x8*)(Cs + (16 * w + fr) * LP + 32 * kn + 8 * fq);
                f32x4 accO[4], accY[4];
#pragma unroll
                for (int pt = 0; pt < 4; ++pt) { accO[pt] = (f32x4){0.f, 0.f, 0.f, 0.f}; accY[pt] = (f32x4){0.f, 0.f, 0.f, 0.f};
#pragma unroll
                    for (int kn = 0; kn < 4; ++kn) { const bf16x8 a = *(const LAS bf16x8*)(Sl + (16 * pt + fr) * LP + 32 * kn + 8 * fq); accO[pt] = __builtin_amdgcn_mfma_f32_16x16x32_bf16(a, cf[kn], accO[pt], 0, 0, 0); } }
                const float acl = acs[l], el = __expf(acl);
#pragma unroll
                for (int pt = 0; pt < 4; ++pt) accY[pt] = accO[pt] * el;
                __builtin_amdgcn_sched_barrier(0);
#pragma unroll
                for (int u = 0; u < 4; ++u) if (2 * u <= w) {
                    f32x4 m0 = mt[2 * u], m1 = {0.f, 0.f, 0.f, 0.f};
                    if (2 * u + 1 <= w) m1 = mt[2 * u + 1];
                    float v0[4], v1[4];
                    const f32x4 as0 = *(const LAS f32x4*)(acs + 32 * u + 4 * fq), as1 = *(const LAS f32x4*)(acs + 32 * u + 16 + 4 * fq);
                    const f32x4 ds0 = *(const LAS f32x4*)(dts + 32 * u + 4 * fq), ds1 = *(const LAS f32x4*)(dts + 32 * u + 16 + 4 * fq);
#pragma unroll
                    for (int jj = 0; jj < 4; ++jj) { const int s0 = 32 * u + 4 * fq + jj, s1 = s0 + 16;
                        const float e0 = __expf(fminf(acl - as0[jj], 0.f)) * ds0[jj], e1 = __expf(fminf(acl - as1[jj], 0.f)) * ds1[jj];
                        const float t0 = m0[jj] * e0, t1 = m1[jj] * e1;
                        v0[jj] = ((s0 <= l) ? t0 : 0.f) + ((s0 == l) ? D_h : 0.f); v1[jj] = ((s1 <= l) ? t1 : 0.f) + ((s1 == l) ? D_h : 0.f); }
                    u32x4 pw; pw.x = pk2(v0[0], v0[1]); pw.y = pk2(v0[2], v0[3]); pw.z = pk2(v1[0], v1[1]); pw.w = pk2(v1[2], v1[3]);
                    const bf16x8 pf = as_bf16x8(pw);
#pragma unroll
                    for (int pt = 0; pt < 4; ++pt) { const int gx = (2 * pt + (fr >> 3)) & 7, jx = 4 * u + (fq >> 1); const LAS bf16_t* xrow = Xt + (16 * pt + fr) * LP + 4 * (fq & 1); const u32x2 x0 = *(const LAS u32x2*)(xrow + 8 * (jx ^ gx)), x1 = *(const LAS u32x2*)(xrow + 8 * ((jx + 2) ^ gx));
                        u32x4 xw; xw.x = x0.x; xw.y = x0.y; xw.z = x1.x; xw.w = x1.y;
                        accY[pt] = __builtin_amdgcn_mfma_f32_16x16x32_bf16(as_bf16x8(xw), pf, accY[pt], 0, 0, 0); } }
#pragma unroll
                for (int pt = 0; pt < 4; ++pt) yv[pt] = accY[pt];
            }
            SSD_LBAR();
#pragma unroll
            for (int pt = 0; pt < 4; ++pt)
#pragma unroll
                for (int jj = 0; jj < 4; ++jj) Sl[(16 * pt + 4 * fq + jj) * LP + 16 * w + fr] = (bf16_t)(pk2(accS[pt][jj], 0.f) & 0xffffu);
            if (doC) { const size_t row = (size_t)(b * TSEQ + 128 * (c - 1) + l); float ss = 0.f;
#pragma unroll
                for (int pt = 0; pt < 4; ++pt) { const u32x2 z_ = zz[pt];
                    const float y0 = yv[pt][0] * silu(lo_f(z_.x)), y1 = yv[pt][1] * silu(hi_f(z_.x)), y2 = yv[pt][2] * silu(lo_f(z_.y)), y3 = yv[pt][3] * silu(hi_f(z_.y));
                    ss += y0 * y0 + y1 * y1 + y2 * y2 + y3 * y3;
                    u32x2 o; o.x = pk2(y0, y1); o.y = pk2(y2, y3); if (!dry) *(u32x2*)(zp + 16 * pt + 4 * fq) = o; }
                ss += __shfl_xor(ss, 16); ss += __shfl_xor(ss, 32);
                if (fq == 0) ssq[row * 32 + h] = ss; }
        }
    }
}

__device__ __forceinline__ void gnorm_phase(const Params& p, bool dry = false) {
    bf16_t* bufB = (bf16_t*)(p.ws + WS_BUF); const float* ssq = (const float*)(p.ws + WS_SSQ);
    const int nthr = gridDim.x * 512;
    for (int v = blockIdx.x * 512 + threadIdx.x; v < NROW * 256; v += nthr) { const int row = v >> 8, rem = v & 255, g = rem >> 6, oc = rem & 63;
        const f32x4 s0 = *(const f32x4*)(ssq + (size_t)row * 32 + 8 * g), s1 = *(const f32x4*)(ssq + (size_t)row * 32 + 8 * g + 4);
        const float rstd = rsqrtf(((s0[0] + s0[1]) + (s0[2] + s0[3]) + (s1[0] + s1[1]) + (s1[2] + s1[3])) * (1.f / 512.f) + EPS);
        bf16_t* ptr = bufB + (size_t)row * LDB_S + 512 * g + 8 * oc; const u32x4 a = *(const u32x4*)ptr; u32x4 o;
        o.x = pk2(lo_f(a.x) * rstd, hi_f(a.x) * rstd); o.y = pk2(lo_f(a.y) * rstd, hi_f(a.y) * rstd); o.z = pk2(lo_f(a.z) * rstd, hi_f(a.z) * rstd); o.w = pk2(lo_f(a.w) * rstd, hi_f(a.w) * rstd);
        if (!dry) *(u32x4*)ptr = o; }
}
__device__ __forceinline__ void final_phase(const Params& p) {
    const int lane = threadIdx.x & 63, wave = threadIdx.x >> 6, G = gridDim.x; const bf16_t* of = (const bf16_t*)(p.ws + WS_BUF);
    f32x4 gg[4];
#pragma unroll
    for (int i = 0; i < 4; ++i) gg[i] = *(const f32x4*)(p.g_post + 4 * lane + 256 * i);
    for (int row0 = blockIdx.x * 8 + wave; row0 < NROW; row0 += G * 32) { u32x2 rv[4][4]; f32x4 xx[4][4];
#pragma unroll
        for (int r = 0; r < 4; ++r) { const int row = row0 + r * G * 8; const int rr = row < NROW ? row : row0;
#pragma unroll
            for (int i = 0; i < 4; ++i) { rv[r][i] = *(const u32x2*)(of + (size_t)rr * DM + 4 * lane + 256 * i); xx[r][i] = *(const f32x4*)(p.x + (size_t)rr * DM + 4 * lane + 256 * i); } }
#pragma unroll
        for (int r = 0; r < 4; ++r) { const int row = row0 + r * G * 8; f32x4 v[4]; float s = 0.f;
#pragma unroll
            for (int i = 0; i < 4; ++i) { v[i] = (f32x4){lo_f(rv[r][i].x), hi_f(rv[r][i].x), lo_f(rv[r][i].y), hi_f(rv[r][i].y)}; s += v[i][0] * v[i][0] + v[i][1] * v[i][1] + v[i][2] * v[i][2] + v[i][3] * v[i][3]; }
            const float rstd = rsqrtf(wave_sum(s) * (1.f / DM) + EPS);
            if (row < NROW) {
#pragma unroll
                for (int i = 0; i < 4; ++i) *(f32x4*)(p.out + (size_t)row * DM + 4 * lane + 256 * i) = xx[r][i] + v[i] * rstd * gg[i]; } } }
}

__global__ void __launch_bounds__(512, 2) fwd_kernel(Params p) {
    extern __shared__ __attribute__((aligned(16))) unsigned char smem[];
    LAS unsigned char* lds = (LAS unsigned char*)smem;
    cg::grid_group grid = cg::this_grid();
    volatile LAS unsigned* bst = (volatile LAS unsigned*)(lds + LDS_BYTES - 16);
    if (threadIdx.x < 4) bst[threadIdx.x] = 0u;
    __syncthreads();
    const XcdBarrier xbar = xcd_barrier_post((unsigned*)(p.ws + WS_BAR), bst);
    if (p.ph_lo == 0x7fffffff) grid.sync();
#define GSYNC() xcd_barrier(xbar)
    unsigned char* ws = p.ws; const int G = gridDim.x, lo = p.ph_lo, hi = p.ph_hi;
    bf16_t* buf = (bf16_t*)(ws + WS_BUF); bf16_t* U = (bf16_t*)(ws + WS_U); bf16_t* m1 = (bf16_t*)p.out;
#ifndef REP0
#define REP0 1
#endif
#ifndef REP1
#define REP1 1
#endif
#ifndef REP2
#define REP2 1
#endif
#ifndef REP3
#define REP3 1
#endif
#ifndef REP4
#define REP4 1
#endif
#ifndef REP5
#define REP5 1
#endif
#ifndef REP6
#define REP6 1
#endif
#ifndef REP7
#define REP7 1
#endif
#ifndef REP8
#define REP8 1
#endif
#ifndef REP9
#define REP9 1
#endif
#ifndef GEMM_SP2
#define GEMM_SP2 true
#endif
#ifndef GEMM_ALIGN
#define GEMM_ALIGN true
#endif
#ifndef PHASE_MASK
#define PHASE_MASK 0x3ff
#endif
#define IN(k) ((((PHASE_MASK) >> (k)) & 1) && lo <= (k) && (k) < hi)
#define SEAM(k) do { if (IN(k) && IN((k) + 1)) { GSYNC(); } } while (0)
#define DRY (REP0 > 1 && rep_ + lo < REP0 - 1)
    if (IN(0)) for (int rep_ = 0; rep_ < REP0; ++rep_) { if (rep_) { GSYNC(); } prep_phase(p, lds); }
#undef DRY
    SEAM(0);
#define DRY (REP1 > 1 && rep_ + lo < REP1 - 1)
    if (IN(1)) for (int rep_ = 0; rep_ < REP1; ++rep_) { if (rep_) { GSYNC(); } { pg8::Gemm g{U, (const bf16_t*)(ws + WS_WT_ATT), NROW, NATT, DM, DM, DM}; pg8::StaticOrder S; S.init(NROW, NATT, G, (int)blockIdx.x);
        EpiAtt E{buf, (float*)(ws + WS_DT), p.dt_bias}; pg8::gemm_phase2<EpiAtt, pg8::StaticOrder, GEMM_ALIGN, GEMM_SP2>(lds, g, S, E); } }
#undef DRY
    SEAM(1);
#define DRY (REP2 > 1 && rep_ + lo < REP2 - 1)
    if (IN(2)) for (int rep_ = 0; rep_ < REP2; ++rep_) { if (rep_) { GSYNC(); } attn_phase(p, lds, DRY); }
#undef DRY
    SEAM(2);
#define DRY (REP3 > 1 && rep_ + lo < REP3 - 1)
    if (IN(3)) for (int rep_ = 0; rep_ < REP3; ++rep_) { if (rep_) { GSYNC(); } { pg8::Gemm g{buf, (const bf16_t*)(ws + WS_WOA), NROW, DM, DM, LDA_A, DM}; pg8::StaticOrder S; S.init(NROW, DM, G, (int)blockIdx.x);
        EpiYatt E{buf, m1}; pg8::gemm_phase2<EpiYatt, pg8::StaticOrder, false, GEMM_SP2>(lds, g, S, E); } }
#undef DRY
    SEAM(3);
#define DRY (REP4 > 1 && rep_ + lo < REP4 - 1)
    if (IN(4)) for (int rep_ = 0; rep_ < REP4; ++rep_) { if (rep_) { GSYNC(); } { pg8::Gemm g{U, (const bf16_t*)(ws + WS_WT_SSM), NROW, LDB_S, DM, DM, DM}; pg8::StaticOrder S; S.init(NROW, LDB_S, G, (int)blockIdx.x);
        EpiStore E{buf, LDB_S}; pg8::gemm_phase2<EpiStore, pg8::StaticOrder, GEMM_ALIGN, GEMM_SP2>(lds, g, S, E); } }
#undef DRY
    SEAM(4);
#define DRY (REP5 > 1 && rep_ + lo < REP5 - 1)
    if (IN(5)) for (int rep_ = 0; rep_ < REP5; ++rep_) { if (rep_) { GSYNC(); } convbc_phase(p, lds); GSYNC(); ssd_phase(p, lds, DRY); }
#undef DRY
    SEAM(5);
    const bool fuse_gn = (G == 256);
    if (IN(6) && !fuse_gn) gnorm_phase(p);
    if (IN(6) && IN(7) && !fuse_gn) { GSYNC(); }
    if (IN(7)) { pg8::Gemm g{buf, (const bf16_t*)(ws + WS_WOS), NROW, DM, 2048, LDB_S, 2048}; pg8::StaticOrder S; S.init(NROW, DM, G, (int)blockIdx.x);
        EpiYssm E{buf, m1, U};
        if (fuse_gn) { LAS float* gtab = (LAS float*)(lds + pg8::STAGE_BYTES);
            pg8::Unit u0; const bool has = S.next(0, u0);
            if (has && threadIdx.x < 256) { const float* sq = (const float*)(ws + WS_SSQ) + (size_t)(u0.pm * 256 + threadIdx.x) * 32; float rs[4];
#pragma unroll
                for (int gg = 0; gg < 4; ++gg) { const f32x4 s0 = *(const f32x4*)(sq + 8 * gg), s1 = *(const f32x4*)(sq + 8 * gg + 4);
                    rs[gg] = rsqrtf(((s0[0] + s0[1]) + (s0[2] + s0[3]) + (s1[0] + s1[1]) + (s1[2] + s1[3])) * (1.f / 512.f) + EPS); }
                gtab[threadIdx.x] = rs[0] / rs[1]; gtab[256 + threadIdx.x] = rs[1] / rs[2]; gtab[512 + threadIdx.x] = rs[2] / rs[3]; gtab[768 + threadIdx.x] = rs[3]; }
            __syncthreads();
            pg8::gemm_phase2<EpiYssm, pg8::StaticOrder, false, GEMM_SP2, true>(lds, g, S, E, gtab); }
        else pg8::gemm_phase2<EpiYssm, pg8::StaticOrder, false, GEMM_SP2>(lds, g, S, E); }
    SEAM(7);
#define DRY (REP8 > 1 && rep_ + lo < REP8 - 1)
    if (IN(8)) for (int rep_ = 0; rep_ < REP8; ++rep_) { if (rep_) { GSYNC(); } { pg8::Gemm g{U, (const bf16_t*)(ws + WS_WO), NROW, DM, DM, DM, DM}; pg8::StaticOrder S; S.init(NROW, DM, G, (int)blockIdx.x);
        EpiStore E{buf, DM}; pg8::gemm_phase2<EpiStore, pg8::StaticOrder, false, GEMM_SP2>(lds, g, S, E); } }
#undef DRY
    SEAM(8);
#define DRY (REP9 > 1 && rep_ + lo < REP9 - 1)
    if (IN(9)) for (int rep_ = 0; rep_ < REP9; ++rep_) { if (rep_) { GSYNC(); } final_phase(p); }
#undef DRY

#ifdef EXTRA_SYNCS
    for (int e_ = 0; e_ < EXTRA_SYNCS; ++e_) { GSYNC(); }
#endif
#ifdef DBG_STOP
    { GSYNC();
      const float* dtb = (const float*)(ws + WS_DT); const float* ssq = (const float*)(ws + WS_SSQ);
      const bf16_t* wa = (const bf16_t*)(ws + WS_WT_ATT); const bf16_t* wsm = (const bf16_t*)(ws + WS_WT_SSM); const bf16_t* woa = (const bf16_t*)(ws + WS_WOA); const bf16_t* wos = (const bf16_t*)(ws + WS_WOS); const bf16_t* wo = (const bf16_t*)(ws + WS_WO);
      const bf16_t* mkv = (const bf16_t*)(ws + WS_MKV); const bf16_t* mxbc = (const bf16_t*)(ws + WS_MXBC); const float* mdt = (const float*)(ws + WS_MDT);
      for (size_t i = (size_t)blockIdx.x * 512 + threadIdx.x; i < (size_t)NROW * DM; i += (size_t)G * 512) { const size_t r = i >> 10; const int c = (int)(i & 1023); float v = 0.f;
#define BF(ptr, idx) __uint_as_float(((unsigned)(ptr)[idx]) << 16)
          if (DBG_KIND == 0) v = BF(U, i) + BF(wa, (r % 3840) * 1024 + c) + BF(wsm, (r % 6144) * 1024 + c) + BF(woa, (r & 1023) * 1024 + c) + BF(wos, (r & 1023) * 2048 + c) + BF(wos, (r & 1023) * 2048 + 1024 + c) + BF(wo, (r & 1023) * 1024 + c)
                               + BF(mkv, (r & 15) * 512 + (c & 511)) + BF(mxbc, (r & 15) * 3072 + c + 1024 * ((r >> 4) % 3)) + mdt[(r & 15) * 32 + (c & 31)];
          if (DBG_KIND == 1) v = BF(buf, r * LDA_A + c) + BF(buf, r * LDA_A + 1024 + c) + BF(buf, r * LDA_A + 2048 + c) + BF(buf, r * LDA_A + 3072 + (c & 511)) + dtb[r * 32 + (c & 31)];
          if (DBG_KIND == 2) v = BF(buf, r * LDB_S + c) + BF(buf, r * LDB_S + 1024 + c) + BF(buf, r * LDB_S + 2048 + c) + BF(buf, r * LDB_S + 3072 + c) + BF(buf, r * LDB_S + 4096 + c) + BF(buf, r * LDB_S + 5120 + c) + ssq[r * 32 + (c & 31)];
          if (DBG_KIND == 5) v = BF(buf, r * LDB_S + c) + BF(buf, r * LDB_S + 1024 + c) + BF(buf, r * LDB_S + 2048 + c) + BF(buf, r * LDB_S + 3072 + c) + BF(buf, r * LDB_S + 4096 + c) + BF(buf, r * LDB_S + 5120 + c);
          if (DBG_KIND == 3) v = BF(U, i);
          if (DBG_KIND == 4) v = BF(buf, i);
          p.out[i] = v; }
    }
#endif
}
}

extern "C" void kernel_launch(void* const* d_in, const int* in_sizes, int n_in, void* d_out, int out_size, void* d_ws, size_t ws_size, hipStream_t stream) {
    using namespace mk;
    static int grid = 0;
    if (grid == 0) {
        if (n_in != 15 || out_size != NROW * DM || ws_size < WS_END) { fprintf(stderr, "kernel_launch: unexpected shapes (n_in %d out %d ws %zu need %zu)\n", n_in, out_size, ws_size, (size_t)WS_END); grid = -1; return; }
        int dev = 0, cus = 0, per_cu = 0;
        (void)hipGetDevice(&dev); (void)hipDeviceGetAttribute(&cus, hipDeviceAttributeMultiprocessorCount, dev);
        if (hipFuncSetAttribute((const void*)fwd_kernel, hipFuncAttributeMaxDynamicSharedMemorySize, LDS_BYTES) != hipSuccess) { fprintf(stderr, "kernel_launch: hipFuncSetAttribute failed\n"); grid = -1; return; }
        if (hipOccupancyMaxActiveBlocksPerMultiprocessor(&per_cu, (const void*)fwd_kernel, 512, LDS_BYTES) != hipSuccess || per_cu < 1) { fprintf(stderr, "kernel_launch: occupancy query gives %d\n", per_cu); (void)hipGetLastError(); grid = -1; return; }
        grid = cus;
    }
    if (grid < 0) return;
    if (hipMemsetAsync((char*)d_ws + WS_BAR, 0, 3456 * 4, stream) != hipSuccess) { fprintf(stderr, "kernel_launch: memset failed\n"); return; }
    Params p{};
    p.x = (const float*)d_in[0]; p.meta = (const float*)d_in[1]; p.g_pre = (const float*)d_in[2]; p.w_in = (const float*)d_in[3]; p.conv_w = (const float*)d_in[4]; p.conv_b = (const float*)d_in[5];
    p.dt_bias = (const float*)d_in[6]; p.a_log = (const float*)d_in[7]; p.d_skip = (const float*)d_in[8]; p.sinks = (const float*)d_in[9]; p.g_ssm = (const float*)d_in[10];
    p.w_oa = (const float*)d_in[11]; p.w_os = (const float*)d_in[12]; p.w_o = (const float*)d_in[13]; p.g_post = (const float*)d_in[14];
    p.out = (float*)d_out; p.ws = (unsigned char*)d_ws; p.ph_lo = 0; p.ph_hi = 10;
#ifdef DBG_STOP
    p.ph_hi = DBG_STOP + 1;
#endif
    void* args[] = {&p};
    hipError_t e = hipLaunchCooperativeKernel((const void*)fwd_kernel, dim3(grid), dim3(512), args, LDS_BYTES, stream);
    if (e != hipSuccess) fprintf(stderr, "kernel_launch: cooperative launch failed: %s (grid %d)\n", hipGetErrorString(e), grid);
}
```

```cpp
#include <hip/hip_runtime.h>
#include <hip/hip_cooperative_groups.h>
#include <cstdio>
namespace cg = cooperative_groups;

namespace pg8 {
#define PG8_LAS __attribute__((address_space(3)))
typedef unsigned short bf16_t;
typedef short bf16x8 __attribute__((ext_vector_type(8)));
typedef float f32x4 __attribute__((ext_vector_type(4)));
typedef unsigned u32x4 __attribute__((ext_vector_type(4)));
constexpr int BM = 256, BK = 64, HALF = 128, HTB = HALF * BK * 2  , STAGE_BYTES = 8 * HTB, NXCD = 8, WGM = 2;

__host__ __device__ __forceinline__ int lds_byte(int r, int c) { const int st = (r >> 4) * 2 + (c >> 5), rr = r & 15, cc = c & 31, ob = rr * 64 + cc * 2; return st * 1024 + (ob ^ (((ob >> 9) & 1) << 5)); }
__host__ __device__ __forceinline__ void stage_rc(int b, int& R, int& C) { const int st = b / 1024, sb = b % 1024, swz = sb ^ (((sb >> 9) & 1) << 5); R = (st >> 1) * 16 + swz / 64; C = (st & 1) * 32 + (swz % 64) / 2; }
__host__ __device__ __forceinline__ int perm32(int rho) { const int n = rho >> 4, i = rho & 15; return 8 * (i >> 2) + 4 * n + (i & 3); }

struct Unit { int pm, pn; };
struct Gemm { const bf16_t* A; const bf16_t* Bt; int M, N, K, lda, ldb; };

struct StaticOrder {
    int nM, nN, nwg, G, c;
    __host__ __device__ void init(int M, int N, int G_, int c_) { nM = M / BM; nN = N / BM; nwg = nM * nN; G = G_; c = c_; }
    __host__ __device__ bool next(int i, Unit& u) const {
        const long L = (long)i * G + c; if (L >= nwg) return false;
        int wgid = (int)L; { const int q = nwg / NXCD, r = nwg % NXCD, xcd = wgid % NXCD, off = wgid / NXCD; wgid = (xcd < r ? xcd * (q + 1) : r * (q + 1) + (xcd - r) * q) + off; }
        const int nig = WGM * nN, gid = wgid / nig, fm = gid * WGM, gsz = (nM - fm) < WGM ? (nM - fm) : WGM;
        u.pm = fm + ((wgid % nig) % gsz); u.pn = (wgid % nig) / gsz; return true;
    }
    __device__ __forceinline__ void a_ready(const Unit&) const {}
    __device__ __forceinline__ void done(const Unit&) const {}
};
template <class Epi, class Sched, bool STAMP = false, bool GSC = false>
__device__ __forceinline__ void gemm_phase(PG8_LAS unsigned char* lds, const Gemm g, const Sched& S, const Epi& E, unsigned long long* stamps, const PG8_LAS float* gtab = nullptr) {
    const int tid = threadIdx.x, wid = __builtin_amdgcn_readfirstlane(tid >> 6), lane = tid & 63, wr = wid >> 2, wc = wid & 3, fr = lane & 15, fq = lane >> 4;
    const int K = g.K, nt = K / BK;
    int ts_lo = 0, ts_hi = 0, nts = 0; const unsigned long long rt_entry = STAMP ? (unsigned long long)wall_clock64() : 0ull;
#define PG8_STAMP() do { if (STAMP && wid == 0 && nts < 64) { const unsigned long long _c = (unsigned long long)clock64(); \
        ts_lo = (lane == nts) ? (int)(unsigned)_c : ts_lo; ts_hi = (lane == nts) ? (int)(unsigned)(_c >> 32) : ts_hi; ++nts; } } while (0)
    PG8_STAMP();
    unsigned voffA[2], voffB[2];
#pragma unroll
    for (int i = 0; i < 2; ++i) { int R, C; stage_rc(tid * 16 + i * 8192, R, C); const int Rb = Epi::PERM ? ((R & ~31) + perm32(R & 31)) : R;
        voffA[i] = (unsigned)(R * g.lda + C) * 2u; voffB[i] = (unsigned)(Rb * g.ldb + C) * 2u; }
    const size_t kstep = (size_t)(BK * 2);
    const size_t hstepA = (size_t)HALF * g.lda * 2, hstepB = (size_t)HALF * g.ldb * 2;
    const size_t tstepA = 2 * hstepA, tstepB = 2 * hstepB;
    const unsigned ldsw = (unsigned)wid * 1024u;
    const int aoff = lds_byte(wr * 64 + fr, fq * 8), boff = lds_byte(wc * 32 + fr, fq * 8);
#define PG8_SA(b, h) (((b) * 2 + (h)) * HTB)
#define PG8_SB(b, h) ((4 + (b) * 2 + (h)) * HTB)
#define PG8_STAGE(bufoff, gbase, voff) do { _Pragma("unroll") for (int _i = 0; _i < 2; ++_i) \
        __builtin_amdgcn_global_load_lds((const unsigned*)((const char*)(gbase) + (voff)[_i]), (PG8_LAS unsigned*)(lds + (bufoff) + ldsw + _i * 8192), 16, 0, 0); } while (0)
#define PG8_LDA(dst, b, h) do { _Pragma("unroll") for (int m = 0; m < 4; ++m) _Pragma("unroll") for (int k = 0; k < 2; ++k) dst[m][k] = *(const PG8_LAS bf16x8*)(lds + PG8_SA(b, h) + aoff + m * 2048 + k * 1024); } while (0)
#define PG8_LDB(dst, b, h) do { _Pragma("unroll") for (int n = 0; n < 2; ++n) _Pragma("unroll") for (int k = 0; k < 2; ++k) dst[n][k] = *(const PG8_LAS bf16x8*)(lds + PG8_SB(b, h) + boff + n * 2048 + k * 1024); } while (0)
#define PG8_MMA(ai, bj, At, Bt) do { __builtin_amdgcn_s_setprio(1); _Pragma("unroll") for (int m = 0; m < 4; ++m) _Pragma("unroll") for (int n = 0; n < 2; ++n) _Pragma("unroll") for (int k = 0; k < 2; ++k) \
        acc[ai][bj][m][n] = __builtin_amdgcn_mfma_f32_16x16x32_bf16(Bt[n][k], At[m][k], acc[ai][bj][m][n], 0, 0, 0); __builtin_amdgcn_s_setprio(0); } while (0)
#define PG8_WAIT_V(n) asm volatile("s_waitcnt vmcnt(" #n ")" ::: "memory")
#define PG8_WAIT_L(n) asm volatile("s_waitcnt lgkmcnt(" #n ")" ::: "memory")
#define PG8_BAR __builtin_amdgcn_s_barrier()
#define PG8_SCHED __builtin_amdgcn_sched_barrier(0)
    Unit cur, nxt; int ui = 0;
    if (!S.next(0, cur)) return;
    f32x4 acc[2][2][4][2];
#pragma unroll
    for (int a = 0; a < 2; ++a)
#pragma unroll
        for (int b = 0; b < 2; ++b)
#pragma unroll
            for (int m = 0; m < 4; ++m)
#pragma unroll
                for (int n = 0; n < 2; ++n) acc[a][b][m][n] = (f32x4){0.f, 0.f, 0.f, 0.f};
    bf16x8 At[4][2], B0[2][2], B1[2][2];
    const char* cA = (const char*)g.A + (size_t)cur.pm * tstepA; const char* cB = (const char*)g.Bt + (size_t)cur.pn * tstepB;
    S.a_ready(cur);
    PG8_STAGE(PG8_SB(0, 0), cB, voffB); PG8_STAGE(PG8_SA(0, 0), cA, voffA); PG8_STAGE(PG8_SB(0, 1), cB + hstepB, voffB); PG8_STAGE(PG8_SA(0, 1), cA + hstepA, voffA);
    if (wr == 1) PG8_BAR;
    PG8_WAIT_V(4); PG8_BAR;
    PG8_STAGE(PG8_SB(1, 0), cB + kstep, voffB); PG8_STAGE(PG8_SA(1, 0), cA + kstep, voffA); PG8_STAGE(PG8_SB(1, 1), cB + hstepB + kstep, voffB);
    PG8_WAIT_V(6); PG8_BAR;
    PG8_STAMP();
    for (;;) {
        const bool has_next = S.next(ui + 1, nxt);
        const char* nA = has_next ? (const char*)g.A + (size_t)nxt.pm * tstepA : cA; const char* nB = has_next ? (const char*)g.Bt + (size_t)nxt.pn * tstepB : cB;
        for (int tg = 0; tg < nt; tg += (GSC ? 8 : nt)) {
        if constexpr (GSC) { if (tg > 0) { const PG8_LAS float* gt = gtab + ((tg >> 3) - 1) * 256 + wr * 64 + fr;
#pragma unroll
            for (int ai = 0; ai < 2; ++ai)
#pragma unroll
                for (int m = 0; m < 4; ++m) { const float rt = gt[ai * HALF + m * 16];
#pragma unroll
                    for (int bj = 0; bj < 2; ++bj)
#pragma unroll
                        for (int n = 0; n < 2; ++n) acc[ai][bj][m][n] = acc[ai][bj][m][n] * rt;
                    PG8_SCHED; }
            PG8_WAIT_L(0); PG8_SCHED; } }
        const int tend = GSC ? tg + 8 : nt;
        for (int t = tg; t < tend; t += 2) {
            const bool last = (t == nt - 2);
            const char* a1 = cA + (size_t)(t + 1) * kstep;
            const char* a2 = last ? nA : cA + (size_t)(t + 2) * kstep; const char* b2 = last ? nB : cB + (size_t)(t + 2) * kstep;
            const char* a3 = a2 + kstep; const char* b3 = b2 + kstep;
            if (last && has_next) S.a_ready(nxt);
            PG8_LDB(B0, 0, 0); PG8_SCHED; PG8_LDA(At, 0, 0); PG8_STAGE(PG8_SA(1, 1), a1 + hstepA, voffA);
            PG8_WAIT_L(8); PG8_BAR; PG8_WAIT_L(0); PG8_MMA(0, 0, At, B0); PG8_BAR; PG8_SCHED;
            PG8_LDB(B1, 0, 1); PG8_STAGE(PG8_SB(0, 0), b2, voffB);
            PG8_BAR; PG8_WAIT_L(0); PG8_MMA(0, 1, At, B1); PG8_BAR;
            PG8_LDA(At, 0, 1); PG8_STAGE(PG8_SA(0, 0), a2, voffA);
            PG8_BAR; PG8_WAIT_L(0); PG8_MMA(1, 0, At, B0); PG8_BAR; PG8_SCHED;
            PG8_STAGE(PG8_SB(0, 1), b2 + hstepB, voffB);
            PG8_WAIT_V(6); PG8_BAR; PG8_MMA(1, 1, At, B1); PG8_BAR;
            PG8_LDB(B0, 1, 0); PG8_SCHED; PG8_LDA(At, 1, 0); PG8_STAGE(PG8_SA(0, 1), a2 + hstepA, voffA);
            PG8_WAIT_L(8); PG8_BAR; PG8_WAIT_L(0); PG8_MMA(0, 0, At, B0); PG8_BAR; PG8_SCHED;
            PG8_LDB(B1, 1, 1); PG8_STAGE(PG8_SB(1, 0), b3, voffB);
            PG8_BAR; PG8_WAIT_L(0); PG8_MMA(0, 1, At, B1); PG8_BAR;
            PG8_LDA(At, 1, 1); PG8_STAGE(PG8_SA(1, 0), a3, voffA);
            PG8_BAR; PG8_WAIT_L(0); PG8_MMA(1, 0, At, B0); PG8_BAR; PG8_SCHED;
            PG8_STAGE(PG8_SB(1, 1), b3 + hstepB, voffB);
            PG8_WAIT_V(6); PG8_BAR; PG8_MMA(1, 1, At, B1); PG8_BAR;
        }
        }
        PG8_STAMP();
        if constexpr (GSC) { const PG8_LAS float* gt = gtab + 3 * 256 + wr * 64 + fr;
#pragma unroll
            for (int ai = 0; ai < 2; ++ai)
#pragma unroll
                for (int m = 0; m < 4; ++m) { const float rt = gt[ai * HALF + m * 16];
#pragma unroll
                    for (int bj = 0; bj < 2; ++bj)
#pragma unroll
                        for (int n = 0; n < 2; ++n) acc[ai][bj][m][n] = acc[ai][bj][m][n] * rt;
                    PG8_SCHED; } }
        if constexpr (!Epi::AFTER_DRAIN) { E(acc, cur, wr, wc, fr, fq); S.done(cur); }
        PG8_STAMP();
        if (!has_next) break;
#pragma unroll
        for (int a = 0; a < 2; ++a)
#pragma unroll
            for (int b = 0; b < 2; ++b)
#pragma unroll
                for (int m = 0; m < 4; ++m)
#pragma unroll
                    for (int n = 0; n < 2; ++n) acc[a][b][m][n] = (f32x4){0.f, 0.f, 0.f, 0.f};
        cur = nxt; cA = nA; cB = nB; ++ui;
    }
    PG8_WAIT_V(0);
    if (wr == 0) PG8_BAR;
    PG8_BAR;
    if constexpr (Epi::AFTER_DRAIN) { E.fused(acc, cur, wr, wc, fr, fq, lds, wid, lane); S.done(cur); }
    PG8_STAMP();
    if (STAMP && wid == 0) { stamps[lane] = lane < nts ? (((unsigned long long)(unsigned)ts_hi << 32) | (unsigned)ts_lo) : 0ull;
        if (lane == 62) stamps[62] = rt_entry; if (lane == 63) stamps[63] = (unsigned long long)wall_clock64(); }
#undef PG8_STAMP
#undef PG8_SA
#undef PG8_SB
#undef PG8_STAGE
#undef PG8_LDA
#undef PG8_LDB
#undef PG8_MMA
#undef PG8_WAIT_V
#undef PG8_WAIT_L
#undef PG8_BAR
#undef PG8_SCHED
}
template <class Epi, class Sched, bool ALIGN_EPI = false, bool SP2 = false, bool GSC = false>
__device__ __forceinline__ void gemm_phase2(PG8_LAS unsigned char* lds, const Gemm g, const Sched& S, const Epi& E, const PG8_LAS float* gtab = nullptr) {
    const int tid = threadIdx.x, wid = __builtin_amdgcn_readfirstlane(tid >> 6), lane = tid & 63, wr = wid >> 2, wc = wid & 3, fr = lane & 15, fq = lane >> 4;
    const int K = g.K, nt = K / BK;
    unsigned voffA[2], voffB[2];
#pragma unroll
    for (int i = 0; i < 2; ++i) { int R, C; stage_rc(tid * 16 + i * 8192, R, C); const int Rb = Epi::PERM ? ((R & ~31) + perm32(R & 31)) : R;
        voffA[i] = (unsigned)(R * g.lda + C) * 2u; voffB[i] = (unsigned)(Rb * g.ldb + C) * 2u; }
    const size_t kstep = (size_t)(BK * 2);
    const size_t hstepA = (size_t)HALF * g.lda * 2, hstepB = (size_t)HALF * g.ldb * 2;
    const size_t tstepA = 2 * hstepA, tstepB = 2 * hstepB;
    const unsigned ldsw = (unsigned)wid * 1024u;
    const int aoff = lds_byte(wr * 64 + fr, fq * 8), boff = lds_byte(wc * 32 + fr, fq * 8);
#define PG8_SA(b, h) (((b) * 2 + (h)) * HTB)
#define PG8_SB(b, h) ((4 + (b) * 2 + (h)) * HTB)
#define PG8_STAGE(bufoff, gbase, voff) do { _Pragma("unroll") for (int _i = 0; _i < 2; ++_i) \
        __builtin_amdgcn_global_load_lds((const unsigned*)((const char*)(gbase) + (voff)[_i]), (PG8_LAS unsigned*)(lds + (bufoff) + ldsw + _i * 8192), 16, 0, 0); } while (0)
#define PG8_LDA(dst, b, h) do { _Pragma("unroll") for (int m = 0; m < 4; ++m) _Pragma("unroll") for (int k = 0; k < 2; ++k) dst[m][k] = *(const PG8_LAS bf16x8*)(lds + PG8_SA(b, h) + aoff + m * 2048 + k * 1024); } while (0)
#define PG8_LDB(dst, b, h) do { _Pragma("unroll") for (int n = 0; n < 2; ++n) _Pragma("unroll") for (int k = 0; k < 2; ++k) dst[n][k] = *(const PG8_LAS bf16x8*)(lds + PG8_SB(b, h) + boff + n * 2048 + k * 1024); } while (0)
#define PG8_MMA(ai, bj, At, Bt) do { __builtin_amdgcn_s_setprio(1); _Pragma("unroll") for (int m = 0; m < 4; ++m) _Pragma("unroll") for (int n = 0; n < 2; ++n) _Pragma("unroll") for (int k = 0; k < 2; ++k) \
        acc[ai][bj][m][n] = __builtin_amdgcn_mfma_f32_16x16x32_bf16(Bt[n][k], At[m][k], acc[ai][bj][m][n], 0, 0, 0); __builtin_amdgcn_s_setprio(0); } while (0)
#define PG8_WAIT_V(n) asm volatile("s_waitcnt vmcnt(" #n ")" ::: "memory")
#define PG8_WAIT_L(n) asm volatile("s_waitcnt lgkmcnt(" #n ")" ::: "memory")
#define PG8_BAR __builtin_amdgcn_s_barrier()
#define PG8_SCHED __builtin_amdgcn_sched_barrier(0)
    Unit cur, nxt; int ui = 0;
    if (!S.next(0, cur)) return;
    f32x4 acc[2][2][4][2];
#pragma unroll
    for (int a = 0; a < 2; ++a)
#pragma unroll
        for (int b = 0; b < 2; ++b)
#pragma unroll
            for (int m = 0; m < 4; ++m)
#pragma unroll
                for (int n = 0; n < 2; ++n) acc[a][b][m][n] = (f32x4){0.f, 0.f, 0.f, 0.f};
    bf16x8 At[4][2], B0[2][2], B1[2][2];
    const char* cA = (const char*)g.A + (size_t)cur.pm * tstepA; const char* cB = (const char*)g.Bt + (size_t)cur.pn * tstepB;
    S.a_ready(cur);
    if constexpr (SP2) {
        PG8_STAGE(PG8_SB(0, 0), cB, voffB); PG8_STAGE(PG8_SB(0, 1), cB + hstepB, voffB); PG8_STAGE(PG8_SA(0, 0), cA, voffA); PG8_STAGE(PG8_SA(0, 1), cA + hstepA, voffA);
        if (wr == 1) PG8_BAR;
        PG8_WAIT_V(2); PG8_BAR;
        PG8_STAGE(PG8_SB(1, 0), cB + kstep, voffB); PG8_STAGE(PG8_SA(1, 0), cA + kstep, voffA); PG8_STAGE(PG8_SB(1, 1), cB + hstepB + kstep, voffB);
        PG8_WAIT_V(6); PG8_BAR;
    } else {
        PG8_STAGE(PG8_SB(0, 0), cB, voffB); PG8_STAGE(PG8_SA(0, 0), cA, voffA); PG8_STAGE(PG8_SB(0, 1), cB + hstepB, voffB); PG8_STAGE(PG8_SA(0, 1), cA + hstepA, voffA);
        if (wr == 1) PG8_BAR;
        PG8_WAIT_V(4); PG8_BAR;
        PG8_STAGE(PG8_SB(1, 0), cB + kstep, voffB); PG8_STAGE(PG8_SA(1, 0), cA + kstep, voffA); PG8_STAGE(PG8_SB(1, 1), cB + hstepB + kstep, voffB);
        PG8_WAIT_V(6); PG8_BAR;
    }
    for (;;) {
        const bool has_next = S.next(ui + 1, nxt);
        const char* nA = has_next ? (const char*)g.A + (size_t)nxt.pm * tstepA : cA; const char* nB = has_next ? (const char*)g.Bt + (size_t)nxt.pn * tstepB : cB;
        for (int tg = 0; tg < nt; tg += (GSC ? 8 : nt)) {
        if constexpr (GSC) { if (tg > 0) { const PG8_LAS float* gt = gtab + ((tg >> 3) - 1) * 256 + wr * 64 + fr;
#pragma unroll
            for (int ai = 0; ai < 2; ++ai)
#pragma unroll
                for (int m = 0; m < 4; ++m) { const float rt = gt[ai * HALF + m * 16];
#pragma unroll
                    for (int bj = 0; bj < 2; ++bj)
#pragma unroll
                        for (int n = 0; n < 2; ++n) acc[ai][bj][m][n] = acc[ai][bj][m][n] * rt;
                    PG8_SCHED; }
            PG8_WAIT_L(0); PG8_SCHED; } }
        const int tend = GSC ? tg + 8 : nt;
        for (int t = tg; t < tend; t += 2) {
            const bool last = (t == nt - 2);
            const char* a1 = cA + (size_t)(t + 1) * kstep;
            const char* a2 = last ? nA : cA + (size_t)(t + 2) * kstep; const char* b2 = last ? nB : cB + (size_t)(t + 2) * kstep;
            const char* a3 = a2 + kstep; const char* b3 = b2 + kstep;
            if (last && has_next) S.a_ready(nxt);
            if constexpr (SP2) {
            PG8_LDB(B0, 0, 0); PG8_LDB(B1, 0, 1); PG8_SCHED; PG8_LDA(At, 0, 0); PG8_STAGE(PG8_SA(1, 1), a1 + hstepA, voffA);
            PG8_WAIT_V(8); PG8_WAIT_L(0); PG8_BAR; PG8_MMA(0, 0, At, B0); PG8_MMA(0, 1, At, B1); PG8_BAR; PG8_SCHED;
            PG8_LDA(At, 0, 1); PG8_STAGE(PG8_SB(0, 0), b2, voffB); PG8_STAGE(PG8_SB(0, 1), b2 + hstepB, voffB); PG8_STAGE(PG8_SA(0, 0), a2, voffA);
            PG8_WAIT_V(8); PG8_WAIT_L(0); PG8_BAR; PG8_MMA(1, 0, At, B0); PG8_MMA(1, 1, At, B1); PG8_BAR; PG8_SCHED;
            PG8_LDB(B0, 1, 0); PG8_LDB(B1, 1, 1); PG8_SCHED; PG8_LDA(At, 1, 0); PG8_STAGE(PG8_SA(0, 1), a2 + hstepA, voffA);
            PG8_WAIT_V(8); PG8_WAIT_L(0); PG8_BAR; PG8_MMA(0, 0, At, B0); PG8_MMA(0, 1, At, B1); PG8_BAR; PG8_SCHED;
            PG8_LDA(At, 1, 1); PG8_STAGE(PG8_SB(1, 0), b3, voffB); PG8_STAGE(PG8_SB(1, 1), b3 + hstepB, voffB); PG8_STAGE(PG8_SA(1, 0), a3, voffA);
            PG8_WAIT_V(8); PG8_WAIT_L(0); PG8_BAR; PG8_MMA(1, 0, At, B0); PG8_MMA(1, 1, At, B1); PG8_BAR; PG8_SCHED;
            } else {
            PG8_LDB(B0, 0, 0); PG8_SCHED; PG8_LDA(At, 0, 0); PG8_STAGE(PG8_SA(1, 1), a1 + hstepA, voffA);
            PG8_WAIT_L(8); PG8_BAR; PG8_WAIT_L(0); PG8_MMA(0, 0, At, B0); PG8_BAR; PG8_SCHED;
            PG8_LDB(B1, 0, 1); PG8_STAGE(PG8_SB(0, 0), b2, voffB);
            PG8_BAR; PG8_WAIT_L(0); PG8_MMA(0, 1, At, B1); PG8_BAR;
            PG8_LDA(At, 0, 1); PG8_STAGE(PG8_SA(0, 0), a2, voffA);
            PG8_BAR; PG8_WAIT_L(0); PG8_MMA(1, 0, At, B0); PG8_BAR; PG8_SCHED;
            PG8_STAGE(PG8_SB(0, 1), b2 + hstepB, voffB);
            PG8_WAIT_V(6); PG8_BAR; PG8_MMA(1, 1, At, B1); PG8_BAR;
            PG8_LDB(B0, 1, 0); PG8_SCHED; PG8_LDA(At, 1, 0); PG8_STAGE(PG8_SA(0, 1), a2 + hstepA, voffA);
            PG8_WAIT_L(8); PG8_BAR; PG8_WAIT_L(0); PG8_MMA(0, 0, At, B0); PG8_BAR; PG8_SCHED;
            PG8_LDB(B1, 1, 1); PG8_STAGE(PG8_SB(1, 0), b3, voffB);
            PG8_BAR; PG8_WAIT_L(0); PG8_MMA(0, 1, At, B1); PG8_BAR;
            PG8_LDA(At, 1, 1); PG8_STAGE(PG8_SA(1, 0), a3, voffA);
            PG8_BAR; PG8_WAIT_L(0); PG8_MMA(1, 0, At, B0); PG8_BAR; PG8_SCHED;
            PG8_STAGE(PG8_SB(1, 1), b3 + hstepB, voffB);
            PG8_WAIT_V(6); PG8_BAR; PG8_MMA(1, 1, At, B1); PG8_BAR;
            }
        }
        }
        if constexpr (GSC) { const PG8_LAS float* gt = gtab + 3 * 256 + wr * 64 + fr;
#pragma unroll
            for (int ai = 0; ai < 2; ++ai)
#pragma unroll
                for (int m = 0; m < 4; ++m) { const float rt = gt[ai * HALF + m * 16];
#pragma unroll
                    for (int bj = 0; bj < 2; ++bj)
#pragma unroll
                        for (int n = 0; n < 2; ++n) acc[ai][bj][m][n] = acc[ai][bj][m][n] * rt;
                    PG8_SCHED; } }
        if constexpr (ALIGN_EPI) { if (wr == 0) PG8_BAR; }
        if constexpr (!Epi::AFTER_DRAIN) { E(acc, cur, wr, wc, fr, fq); S.done(cur); }
        if (!has_next) break;
#pragma unroll
        for (int a = 0; a < 2; ++a)
#pragma unroll
            for (int b = 0; b < 2; ++b)
#pragma unroll
                for (int m = 0; m < 4; ++m)
#pragma unroll
                    for (int n = 0; n < 2; ++n) acc[a][b][m][n] = (f32x4){0.f, 0.f, 0.f, 0.f};
        cur = nxt; cA = nA; cB = nB; ++ui;
        if constexpr (ALIGN_EPI) { if (wr == 1) PG8_BAR; }
    }
    PG8_WAIT_V(0);
    if constexpr (!ALIGN_EPI) { if (wr == 0) PG8_BAR; }
    PG8_BAR;
    if constexpr (Epi::AFTER_DRAIN) { E.fused(acc, cur, wr, wc, fr, fq, lds, wid, lane); S.done(cur); }
#undef PG8_SA
#undef PG8_SB
#undef PG8_STAGE
#undef PG8_LDA
#undef PG8_LDB
#undef PG8_MMA
#undef PG8_WAIT_V
#undef PG8_WAIT_L
#undef PG8_BAR
#undef PG8_SCHED
}
}

namespace mk {
using pg8::bf16_t; using pg8::bf16x8; using pg8::f32x4; using pg8::u32x4;
#define LAS __attribute__((address_space(3)))
typedef unsigned u32x2 __attribute__((ext_vector_type(2)));

constexpr int DM = 1024, NBATCH = 8, TSEQ = 2048, NROW = NBATCH * TSEQ;
constexpr int NIN = 9760;
constexpr int LDA_A = 3584;
constexpr int NATT = 3840;
constexpr int LDB_S = 6144;
constexpr float EPS = 1e-6f;
constexpr int LDS_BYTES = 144 * 1024;

constexpr size_t WS_WT_ATT = 0;
constexpr size_t WS_WT_SSM = WS_WT_ATT + (size_t)NATT * DM * 2;
constexpr size_t WS_WOA    = WS_WT_SSM + (size_t)LDB_S * DM * 2;
constexpr size_t WS_WOS    = WS_WOA + (size_t)DM * DM * 2;
constexpr size_t WS_WO     = WS_WOS + (size_t)DM * 2048 * 2;
constexpr size_t WS_U      = WS_WO + (size_t)DM * DM * 2;
constexpr size_t WS_DT     = WS_U + (size_t)NROW * DM * 2;
constexpr size_t WS_SSQ    = WS_DT + (size_t)NROW * 32 * 4;
constexpr size_t WS_MKV    = WS_SSQ + (size_t)NROW * 32 * 4;
constexpr size_t WS_MXBC   = WS_MKV + 16 * 512 * 2;
constexpr size_t WS_MDT    = WS_MXBC + 16 * 3072 * 2;
constexpr size_t WS_BUF    = WS_MDT + 16 * 32 * 4;
constexpr size_t WS_BAR    = WS_BUF + (size_t)NROW * LDB_S * 2;
constexpr size_t WS_MCB    = WS_BAR + 3456 * 4;
constexpr size_t WS_END    = WS_MCB + 16 * 1024 * 2;

struct Params {
    const float *x, *meta, *g_pre, *w_in, *conv_w, *conv_b, *dt_bias, *a_log, *d_skip, *sinks, *g_ssm, *w_oa, *w_os, *w_o, *g_post;
    float* out; unsigned char* ws; int ph_lo, ph_hi;
};

typedef __bf16 bf16v2 __attribute__((ext_vector_type(2)));
typedef float f32v2 __attribute__((ext_vector_type(2)));
__device__ __forceinline__ unsigned pk2(float lo, float hi) { const f32v2 v = {lo, hi}; const bf16v2 b = __builtin_convertvector(v, bf16v2); return __builtin_bit_cast(unsigned, b); }
__device__ __forceinline__ float lo_f(unsigned w) { return __uint_as_float(w << 16); }
__device__ __forceinline__ float hi_f(unsigned w) { return __uint_as_float(w & 0xffff0000u); }
__device__ __forceinline__ float sigm(float x) { return __builtin_amdgcn_rcpf(1.f + __expf(-x)); }
__device__ __forceinline__ float silu(float x) { return x * __builtin_amdgcn_rcpf(1.f + __expf(-x)); }
__device__ __forceinline__ float softplus(float x) { const float e = __expf(-fabsf(x)); const float ser = e * (1.f - e * (0.5f - e * 0.333333343f)), lg = __logf(1.f + e); return fmaxf(x, 0.f) + (e < 0.03f ? ser : lg); }
template <int CTRL, int ROWMASK> __device__ __forceinline__ float dpp_add(float v) { return v + __builtin_bit_cast(float, __builtin_amdgcn_update_dpp(0, __builtin_bit_cast(int, v), CTRL, ROWMASK, 0xf, true)); }
__device__ __forceinline__ float wave_scan(float v) {
    v = dpp_add<0x111, 0xf>(v); v = dpp_add<0x112, 0xf>(v); v = dpp_add<0x114, 0xf>(v); v = dpp_add<0x118, 0xf>(v);
    v = dpp_add<0x142, 0xa>(v); v = dpp_add<0x143, 0xc>(v); return v;
}
__device__ __forceinline__ float wave_sum(float v) { v = wave_scan(v); return __builtin_bit_cast(float, __builtin_amdgcn_readlane(__builtin_bit_cast(int, v), 63)); }
__device__ __forceinline__ bf16x8 as_bf16x8(u32x4 v) { union { u32x4 u; bf16x8 b; } c; c.u = v; return c.b; }


#define XB_TMO      128
#define XB_XCNT(j)  (256  + 64 * (j))
#define XB_XSUB(j)  (1280 + 64 * (j))
#define XB_XGEN(j)  (2304 + 64 * (j))
#define XB_TOP      3328
#define XB_TOPGEN   3392
#define XCD_BAR_WORDS 3456
#define XB_SPIN_CAP (1u << 18)
__device__ __forceinline__ unsigned xb_ld(unsigned* p)              { return __hip_atomic_load(p, __ATOMIC_RELAXED, __HIP_MEMORY_SCOPE_AGENT); }
__device__ __forceinline__ unsigned xb_add(unsigned* p, unsigned v) { return __hip_atomic_fetch_add(p, v, __ATOMIC_RELAXED, __HIP_MEMORY_SCOPE_AGENT); }
__device__ __forceinline__ unsigned xb_xcc_id() { return (unsigned)__builtin_amdgcn_s_getreg((3 << 11) | 20) & 0xFu; }
#define XB_SPIN(cond, bar) do { unsigned _sp = 0; while (cond) { __builtin_amdgcn_s_sleep(1); \
    if ((++_sp & 255u) == 0u) { if (xb_ld(&(bar)[XB_TMO])) break; if (_sp > XB_SPIN_CAP) { atomicAdd(&(bar)[XB_TMO], 1u); break; } } } } while (0)
struct XcdBarrier { unsigned* bar; unsigned x; volatile LAS unsigned* st; };
__device__ __forceinline__ XcdBarrier xcd_barrier_post(unsigned* bar, volatile LAS unsigned* st) {
    XcdBarrier b; b.bar = bar; b.x = xb_xcc_id(); b.st = st;
    if (threadIdx.x == 0) (void)xb_add(&bar[XB_XCNT(b.x)], 1u);
    return b;
}
__device__ __forceinline__ void xcd_barrier_complete(unsigned* bar, unsigned x, unsigned& nloc, unsigned& nx) {
    const unsigned G = gridDim.x * gridDim.y * gridDim.z;
    unsigned sum, cnt, mine, sp = 0u;
    for (;;) {
        sum = 0u; cnt = 0u; mine = 0u;
#pragma unroll
        for (unsigned j = 0; j < 16; ++j) { const unsigned c = xb_ld(&bar[XB_XCNT(j)]); sum += c; cnt += (c > 0u) ? 1u : 0u; mine = (j == x) ? c : mine; }
        if (sum == G) break;
        __builtin_amdgcn_s_sleep(1);
        if ((++sp & 255u) == 0u) { if (xb_ld(&bar[XB_TMO])) break; if (sp > XB_SPIN_CAP) { atomicAdd(&bar[XB_TMO], 1u); break; } }
    }
    nloc = mine > 0u ? mine : 1u; nx = cnt > 0u ? cnt : 1u;
}
__device__ __forceinline__ void xcd_barrier(const XcdBarrier& b) {
    asm volatile("s_waitcnt vmcnt(0)" ::: "memory");
    __syncthreads();
    if (threadIdx.x == 0) {
        unsigned* bar = b.bar;
        __builtin_amdgcn_s_waitcnt(0);
        unsigned nloc = b.st[0], nx = b.st[1];
        if (nloc == 0u) { xcd_barrier_complete(bar, b.x, nloc, nx); b.st[0] = nloc; b.st[1] = nx; }
        const unsigned old = xb_add(&bar[XB_XSUB(b.x)], 1u);
        const unsigned gen = old / nloc;
        if (old + 1u == (gen + 1u) * nloc) {
            __builtin_amdgcn_fence(__ATOMIC_RELEASE, "agent");
            asm volatile("s_waitcnt vmcnt(0)" ::: "memory");
            const unsigned og = xb_add(&bar[XB_TOP], 1u);
            const unsigned tg = og / nx;
            if (og + 1u == (tg + 1u) * nx) xb_add(&bar[XB_TOPGEN], 1u);
            else XB_SPIN(xb_ld(&bar[XB_TOPGEN]) == tg, bar);
            __builtin_amdgcn_fence(__ATOMIC_ACQUIRE, "agent");
            xb_add(&bar[XB_XGEN(b.x)], 1u);
            asm volatile("s_waitcnt vmcnt(0)" ::: "memory");
        } else {
            XB_SPIN(xb_ld(&bar[XB_XGEN(b.x)]) == gen, bar);
            __builtin_amdgcn_fence(__ATOMIC_ACQUIRE, "agent");
            asm volatile("s_waitcnt vmcnt(0)" ::: "memory");
        }
    }
    __syncthreads();
}

struct EpiStore {
    static constexpr bool PERM = true, AFTER_DRAIN = false;
    bf16_t* O; int ldc;
    __device__ __forceinline__ void operator()(const f32x4 (&acc)[2][2][4][2], const pg8::Unit& u, int wr, int wc, int fr, int fq) const {
        const int row0 = u.pm * 256 + wr * 64 + fr, col0 = u.pn * 256 + wc * 32 + 8 * fq;
#pragma unroll
        for (int ai = 0; ai < 2; ++ai)
#pragma unroll
            for (int m = 0; m < 4; ++m) { bf16_t* rowp = O + (size_t)(row0 + ai * 128 + m * 16) * ldc + col0;
#pragma unroll
                for (int bj = 0; bj < 2; ++bj) { const f32x4 v0 = acc[ai][bj][m][0], v1 = acc[ai][bj][m][1];
                    u32x4 w; w.x = pk2(v0[0], v0[1]); w.y = pk2(v0[2], v0[3]); w.z = pk2(v1[0], v1[1]); w.w = pk2(v1[2], v1[3]);
                    *(u32x4*)(rowp + bj * 128) = w; } }
    }
};
struct EpiAtt {
    static constexpr bool PERM = true, AFTER_DRAIN = false;
    bf16_t* O; float* dt; const float* dt_bias;
    __device__ __forceinline__ void operator()(const f32x4 (&acc)[2][2][4][2], const pg8::Unit& u, int wr, int wc, int fr, int fq) const {
        const int row0 = u.pm * 256 + wr * 64 + fr;
        if (u.pn < 14) { EpiStore e{O, LDA_A}; e(acc, u, wr, wc, fr, fq); }
        else if (wc == 0) {
#pragma unroll
            for (int n = 0; n < 2; ++n) { const int col = 8 * fq + 4 * n; const f32x4 bv = *(const f32x4*)(dt_bias + col);
#pragma unroll
                for (int ai = 0; ai < 2; ++ai)
#pragma unroll
                    for (int m = 0; m < 4; ++m) { const f32x4 v = acc[ai][0][m][n] + bv; f32x4 o; o[0] = softplus(v[0]); o[1] = softplus(v[1]); o[2] = softplus(v[2]); o[3] = softplus(v[3]);
                        *(f32x4*)(dt + (size_t)(row0 + ai * 128 + m * 16) * 32 + col) = o; } }
        }
    }
};
struct EpiYatt {
    static constexpr bool PERM = true, AFTER_DRAIN = false;
    const bf16_t* bufA; bf16_t* m1;
    __device__ __forceinline__ void operator()(const f32x4 (&acc)[2][2][4][2], const pg8::Unit& u, int wr, int wc, int fr, int fq) const {
        const int row0 = u.pm * 256 + wr * 64 + fr, col0 = u.pn * 256 + wc * 32 + 8 * fq;
        u32x4 gt[2][4][2];
#pragma unroll
        for (int ai = 0; ai < 2; ++ai)
#pragma unroll
            for (int m = 0; m < 4; ++m)
#pragma unroll
                for (int bj = 0; bj < 2; ++bj) gt[ai][m][bj] = *(const u32x4*)(bufA + (size_t)(row0 + ai * 128 + m * 16) * LDA_A + 2560 + col0 + bj * 128);
        __builtin_amdgcn_sched_barrier(0);
#pragma unroll
        for (int ai = 0; ai < 2; ++ai)
#pragma unroll
            for (int m = 0; m < 4; ++m) { const size_t row = (size_t)(row0 + ai * 128 + m * 16);
#pragma unroll
                for (int bj = 0; bj < 2; ++bj) { const int col = col0 + bj * 128; const f32x4 v0 = acc[ai][bj][m][0], v1 = acc[ai][bj][m][1]; const u32x4 g_ = gt[ai][m][bj];
                    u32x4 w; w.x = pk2(v0[0] * sigm(lo_f(g_.x)), v0[1] * sigm(hi_f(g_.x))); w.y = pk2(v0[2] * sigm(lo_f(g_.y)), v0[3] * sigm(hi_f(g_.y)));
                    w.z = pk2(v1[0] * sigm(lo_f(g_.z)), v1[1] * sigm(hi_f(g_.z))); w.w = pk2(v1[2] * sigm(lo_f(g_.w)), v1[3] * sigm(hi_f(g_.w)));
                    *(u32x4*)(m1 + row * DM + col) = w; } }
    }
};
struct EpiYssm {
    static constexpr bool PERM = true, AFTER_DRAIN = false;
    const bf16_t* bufB; const bf16_t* m1; bf16_t* mg;
    __device__ __forceinline__ void operator()(const f32x4 (&acc)[2][2][4][2], const pg8::Unit& u, int wr, int wc, int fr, int fq) const {
        const int row0 = u.pm * 256 + wr * 64 + fr, col0 = u.pn * 256 + wc * 32 + 8 * fq;
#pragma unroll
        for (int ai = 0; ai < 2; ++ai) { u32x4 gt[4][2], mm_[4][2];
#pragma unroll
            for (int m = 0; m < 4; ++m)
#pragma unroll
                for (int bj = 0; bj < 2; ++bj) { const size_t row = (size_t)(row0 + ai * 128 + m * 16); const int col = col0 + bj * 128;
                    gt[m][bj] = *(const u32x4*)(bufB + row * LDB_S + 5120 + col); mm_[m][bj] = *(const u32x4*)(m1 + row * DM + col); }
            __builtin_amdgcn_sched_barrier(0);
#pragma unroll
            for (int m = 0; m < 4; ++m) { const size_t row = (size_t)(row0 + ai * 128 + m * 16);
#pragma unroll
                for (int bj = 0; bj < 2; ++bj) { const int col = col0 + bj * 128; const f32x4 v0 = acc[ai][bj][m][0], v1 = acc[ai][bj][m][1]; const u32x4 g_ = gt[m][bj], mm = mm_[m][bj];
                    u32x4 w; w.x = pk2(lo_f(mm.x) + v0[0] * sigm(lo_f(g_.x)), hi_f(mm.x) + v0[1] * sigm(hi_f(g_.x))); w.y = pk2(lo_f(mm.y) + v0[2] * sigm(lo_f(g_.y)), hi_f(mm.y) + v0[3] * sigm(hi_f(g_.y)));
                    w.z = pk2(lo_f(mm.z) + v1[0] * sigm(lo_f(g_.z)), hi_f(mm.z) + v1[1] * sigm(hi_f(g_.z))); w.w = pk2(lo_f(mm.w) + v1[2] * sigm(lo_f(g_.w)), hi_f(mm.w) + v1[3] * sigm(hi_f(g_.w)));
                    *(u32x4*)(mg + row * DM + col) = w; } }
            __builtin_amdgcn_sched_barrier(0); }
    }
};
struct EpiF32 {
    static constexpr bool PERM = false, AFTER_DRAIN = false;
    float* C; int ldc;
    __device__ __forceinline__ void operator()(const f32x4 (&acc)[2][2][4][2], const pg8::Unit& u, int wr, int wc, int fr, int fq) const {
        const int row0 = u.pm * 256 + wr * 64 + fr, col0 = u.pn * 256 + wc * 32 + 4 * fq;
#pragma unroll
        for (int ai = 0; ai < 2; ++ai)
#pragma unroll
            for (int m = 0; m < 4; ++m) { float* rowp = C + (size_t)(row0 + ai * 128 + m * 16) * ldc + col0;
#pragma unroll
                for (int bj = 0; bj < 2; ++bj)
#pragma unroll
                    for (int n = 0; n < 2; ++n) *(f32x4*)(rowp + bj * 128 + n * 16) = acc[ai][bj][m][n]; }
    }
};

__device__ __forceinline__ void prep_phase(const Params& p, LAS unsigned char* lds) {
    const int tid = threadIdx.x, lane = tid & 63, wave = __builtin_amdgcn_readfirstlane(tid >> 6), G = gridDim.x;
    unsigned char* ws = p.ws;
    for (int ci = blockIdx.x; ci < 226; ci += G) {
        LAS float* um = (LAS float*)lds;
        LAS float* Wl = (LAS float*)(lds + 65536);
        LAS float* red = (LAS float*)(lds + 131072);
        const int c0 = ci < 32 ? 1024 + 16 * ci : (ci < 224 ? 4608 + 16 * (ci - 32) : 7680 + 16 * (ci - 224));
        __syncthreads();
#pragma unroll
        for (int rr = 0; rr < 2; ++rr) { const int r = 2 * wave + rr; f32x4 v[4]; float s = 0.f;
#pragma unroll
            for (int i = 0; i < 4; ++i) { v[i] = *(const f32x4*)(p.meta + r * DM + 4 * lane + 256 * i); s += v[i][0] * v[i][0] + v[i][1] * v[i][1] + v[i][2] * v[i][2] + v[i][3] * v[i][3]; }
            const float rstd = rsqrtf(wave_sum(s) * (1.f / DM) + EPS);
#pragma unroll
            for (int i = 0; i < 4; ++i) { const f32x4 gg = *(const f32x4*)(p.g_pre + 4 * lane + 256 * i); *(LAS f32x4*)(um + r * DM + 4 * lane + 256 * i) = v[i] * rstd * gg; } }
#pragma unroll
        for (int i = 0; i < 8; ++i) { const int idx = tid + 512 * i, k = idx >> 2, c4 = idx & 3; *(LAS f32x4*)(Wl + k * 16 + 4 * c4) = *(const f32x4*)(p.w_in + (size_t)k * NIN + c0 + 4 * c4); }
        __syncthreads();
        { const int c = tid & 15, r = (tid >> 4) & 15, kh = tid >> 8; float s = 0.f;
          for (int k = 512 * kh; k < 512 * kh + 512; k += 4) { const f32x4 uu = *(const LAS f32x4*)(um + r * DM + k);
              s += uu[0] * Wl[(k + 0) * 16 + c] + uu[1] * Wl[(k + 1) * 16 + c] + uu[2] * Wl[(k + 2) * 16 + c] + uu[3] * Wl[(k + 3) * 16 + c]; }
          red[kh * 256 + (tid & 255)] = s; }
        __syncthreads();
        if (tid < 256) { const float s = red[tid] + red[256 + tid]; const int c = tid & 15, r = tid >> 4;
            if (ci < 32) ((bf16_t*)(ws + WS_MKV))[r * 512 + 16 * ci + c] = (bf16_t)(pk2(s, 0.f) & 0xffffu);
            else if (ci < 224) ((bf16_t*)(ws + WS_MXBC))[r * 3072 + 16 * (ci - 32) + c] = (bf16_t)(pk2(s, 0.f) & 0xffffu);
            else { const int j = 16 * (ci - 224) + c; ((float*)(ws + WS_MDT))[r * 32 + j] = softplus(s + p.dt_bias[j]); } }
        __syncthreads();
    }
    {   constexpr int T_ATT = (NATT / 64) * 16, T_SSM = (LDB_S / 64) * 16, T_OA = 256, T_OS = 512, T_O = 256, T_ALL = T_ATT + T_SSM + T_OA + T_OS + T_O, NT = 4;
        const int kk = tid >> 4, c4 = tid & 15;
        for (int it0 = blockIdx.x; it0 < T_ALL; it0 += NT * G) {
            f32x4 v[NT][2]; float sc[NT][2]; bf16_t* dptr[NT]; bool live[NT];
#pragma unroll
            for (int q = 0; q < NT; ++q) { const int it = it0 + q * G; live[q] = it < T_ALL;
                const float* src = p.w_o; int ld = DM, K = DM, n0 = 0, k0 = 0, scol = 0, nvalid = 64; bf16_t* dst = (bf16_t*)(ws + WS_WO); const float* kscale = nullptr; int r = live[q] ? it : 0;
                if (r < T_ATT) { src = p.w_in; ld = NIN; K = DM; n0 = 64 * (r >> 4); k0 = 64 * (r & 15); dst = (bf16_t*)(ws + WS_WT_ATT);
                    if (n0 < 2560) scol = n0; else if (n0 < 3584) scol = 7712 + (n0 - 2560); else if (n0 == 3584) { scol = 7680; nvalid = 32; } else nvalid = 0; }
                else if ((r -= T_ATT) < T_SSM) { src = p.w_in; ld = NIN; K = DM; n0 = 64 * (r >> 4); k0 = 64 * (r & 15); dst = (bf16_t*)(ws + WS_WT_SSM);
                    if (n0 < 2048) scol = 2560 + n0; else if (n0 < 5120) scol = 4608 + (n0 - 2048); else scol = 8736 + (n0 - 5120); }
                else if ((r -= T_SSM) < T_OA) { src = p.w_oa; ld = DM; K = DM; n0 = 64 * (r >> 4); k0 = 64 * (r & 15); dst = (bf16_t*)(ws + WS_WOA); scol = n0; }
                else if ((r -= T_OA) < T_OS) { src = p.w_os; ld = DM; K = 2048; n0 = 64 * (r >> 5); k0 = 64 * (r & 31); dst = (bf16_t*)(ws + WS_WOS); scol = n0; kscale = p.g_ssm; }
                else { r -= T_OS; src = p.w_o; ld = DM; K = DM; n0 = 64 * (r >> 4); k0 = 64 * (r & 15); dst = (bf16_t*)(ws + WS_WO); scol = n0; }
                const bool ok = 4 * c4 < nvalid; const int sc_ = ok ? scol : 0;
#pragma unroll
                for (int rep = 0; rep < 2; ++rep) { const int k = k0 + kk + 32 * rep;
                    v[q][rep] = *(const f32x4*)(src + (size_t)k * ld + sc_ + 4 * c4);
                    sc[q][rep] = !ok ? 0.f : (kscale ? kscale[k] : 1.f); }
                dptr[q] = dst + (size_t)(n0 + (tid >> 3)) * K + k0 + 8 * (tid & 7); }
#pragma unroll
            for (int q = 0; q < NT; ++q) { LAS float* tile = (LAS float*)lds + q * (64 * 65);
#pragma unroll
                for (int rep = 0; rep < 2; ++rep) { const int k = kk + 32 * rep; const f32x4 t = v[q][rep] * sc[q][rep];
                    tile[k * 65 + 4 * c4 + 0] = t[0]; tile[k * 65 + 4 * c4 + 1] = t[1]; tile[k * 65 + 4 * c4 + 2] = t[2]; tile[k * 65 + 4 * c4 + 3] = t[3]; } }
            __syncthreads();
#pragma unroll
            for (int q = 0; q < NT; ++q) { const int n = tid >> 3, k8 = tid & 7; const LAS float* t = (const LAS float*)lds + q * (64 * 65) + (8 * k8) * 65 + n;
                u32x4 o; o.x = pk2(t[0], t[65]); o.y = pk2(t[2 * 65], t[3 * 65]); o.z = pk2(t[4 * 65], t[5 * 65]); o.w = pk2(t[6 * 65], t[7 * 65]);
                if (live[q]) *(u32x4*)dptr[q] = o; }
            __syncthreads();
        }
    }
    {   bf16_t* U = (bf16_t*)(ws + WS_U);
        f32x4 gg[4];
#pragma unroll
        for (int i = 0; i < 4; ++i) gg[i] = *(const f32x4*)(p.g_pre + 4 * lane + 256 * i);
        for (int row0 = blockIdx.x * 8 + wave; row0 < NROW; row0 += G * 32) { f32x4 v[4][4];
#pragma unroll
            for (int r = 0; r < 4; ++r) { const int row = row0 + r * G * 8; const int rr = row < NROW ? row : row0;
#pragma unroll
                for (int i = 0; i < 4; ++i) v[r][i] = *(const f32x4*)(p.x + (size_t)rr * DM + 4 * lane + 256 * i); }
#pragma unroll
            for (int r = 0; r < 4; ++r) { const int row = row0 + r * G * 8; float s = 0.f;
#pragma unroll
                for (int i = 0; i < 4; ++i) s += v[r][i][0] * v[r][i][0] + v[r][i][1] * v[r][i][1] + v[r][i][2] * v[r][i][2] + v[r][i][3] * v[r][i][3];
                const float rstd = rsqrtf(wave_sum(s) * (1.f / DM) + EPS);
                if (row < NROW) {
#pragma unroll
                    for (int i = 0; i < 4; ++i) { const f32x4 o = v[r][i] * rstd * gg[i];
                        u32x2 w; w.x = pk2(o[0], o[1]); w.y = pk2(o[2], o[3]); *(u32x2*)(U + (size_t)row * DM + 4 * lane + 256 * i) = w; } } } }
    }
}

__device__ __forceinline__ void attn_phase(const Params& p, LAS unsigned char* lds, bool dry = false) {
    const int tid = threadIdx.x, lane = tid & 63, wave = __builtin_amdgcn_readfirstlane(tid >> 6), fr = lane & 15, fq = lane >> 4;
    constexpr int KP = 72, VP = 296;
    LAS bf16_t* Ks = (LAS bf16_t*)lds;
    LAS bf16_t* Vt = (LAS bf16_t*)(lds + 288 * KP * 2);
    bf16_t* bufA = (bf16_t*)(p.ws + WS_BUF); const bf16_t* mkv = (const bf16_t*)(p.ws + WS_MKV);
    for (int item = blockIdx.x; item < 512; item += gridDim.x) {
        const int b = item & 7, g = (item >> 3) & 3, j = item >> 5;
        __syncthreads();
        {
            u32x4 kv[5], vv[5];
#pragma unroll
            for (int it = 0; it < 5; ++it) { const int idx = tid + 512 * it, ic = idx < 288 * 8 ? idx : 0, oc = ic / 288, s = ic - 288 * oc, tk = 128 * j - 160 + s;
                const bf16_t* kp = (s < 16) ? mkv + s * 512 + 64 * g + 8 * oc : bufA + (size_t)(b * TSEQ + (tk > 0 ? tk : 0)) * LDA_A + 1024 + 64 * g + 8 * oc;
                kv[it] = *(const u32x4*)kp; vv[it] = *(const u32x4*)(kp + 256); }
#pragma unroll
            for (int it = 0; it < 5; ++it) { const int idx = tid + 512 * it;
                if (idx < 288 * 8) { const int oc = idx / 288, s = idx - 288 * oc, tk = 128 * j - 160 + s; const bool keep = (s < 16) || (s >= 32 && tk >= 0);
                    u32x4 k_ = kv[it], v_ = vv[it]; if (!keep) { k_ = (u32x4){0u, 0u, 0u, 0u}; v_ = k_; }
                    *(LAS u32x4*)(Ks + s * KP + 8 * oc) = k_;
                    LAS bf16_t* vp = Vt + (8 * oc) * VP + s;
                    vp[0 * VP] = (bf16_t)(v_.x & 0xffffu); vp[1 * VP] = (bf16_t)(v_.x >> 16); vp[2 * VP] = (bf16_t)(v_.y & 0xffffu); vp[3 * VP] = (bf16_t)(v_.y >> 16);
                    vp[4 * VP] = (bf16_t)(v_.z & 0xffffu); vp[5 * VP] = (bf16_t)(v_.z >> 16); vp[6 * VP] = (bf16_t)(v_.w & 0xffffu); vp[7 * VP] = (bf16_t)(v_.w >> 16); } }
        }
        __syncthreads();
        const int hq = wave >> 1, half = wave & 1, H = 4 * g + hq;
        const float slope = exp2f(-0.5f * (float)(H + 1)), sink = p.sinks[H];
        bf16x8 qn[2]; u32x2 zn[4];
        { const bf16_t* rp0 = bufA + (size_t)(b * TSEQ + 128 * j + 64 * half + fr) * LDA_A + 64 * H;
          qn[0] = *(const bf16x8*)(rp0 + 8 * fq); qn[1] = *(const bf16x8*)(rp0 + 32 + 8 * fq);
#pragma unroll
          for (int dt = 0; dt < 4; ++dt) zn[dt] = *(const u32x2*)(rp0 + 1536 + 16 * dt + 4 * fq); }
#pragma unroll 1
        for (int qt = 0; qt < 4; ++qt) {
            const int tq = 128 * j + 64 * half + 16 * qt + fr;
            bf16_t* rowp = bufA + (size_t)(b * TSEQ + tq) * LDA_A;
            bf16x8 qf[2]; u32x2 zc[4];
            qf[0] = qn[0]; qf[1] = qn[1];
#pragma unroll
            for (int dt = 0; dt < 4; ++dt) zc[dt] = zn[dt];
            if (qt < 3) { const bf16_t* rp1 = rowp + (size_t)16 * LDA_A + 64 * H;
                qn[0] = *(const bf16x8*)(rp1 + 8 * fq); qn[1] = *(const bf16x8*)(rp1 + 32 + 8 * fq);
#pragma unroll
                for (int dt = 0; dt < 4; ++dt) zn[dt] = *(const u32x2*)(rp1 + 1536 + 16 * dt + 4 * fq); }
            const float g4 = 8.f * slope * (float)(4 * fq);
            f32x4 sa[18];
#pragma unroll
            for (int st = 0; st < 18; ++st) { f32x4 a = {0.f, 0.f, 0.f, 0.f};
                if (st >= 2) a = (f32x4){g4, g4, g4, g4};
                if (st != 1) {
#pragma unroll
                    for (int ks = 0; ks < 2; ++ks) { const bf16x8 kf = *(const LAS bf16x8*)(Ks + (16 * st + fr) * KP + 32 * ks + 8 * fq); a = __builtin_amdgcn_mfma_f32_16x16x32_bf16(kf, qf[ks], a, 0, 0, 0); } }
                sa[st] = a; if ((st & 7) == 7) __builtin_amdgcn_sched_barrier(0); }
            const float r8 = 8.f * slope, sc2 = 0.125f * 1.44269504f;
            const int R1 = tq - (128 * j - 160) - 4 * fq;
            const unsigned hi = (j == 0) ? (unsigned)tq : 127u;
            const float c0 = -r8 * (float)(R1 + 4 * fq);
            float mx = 8.f * sink - c0;
#pragma unroll
            for (int st = 0; st < 18; ++st)
#pragma unroll
                for (int jj = 0; jj < 4; ++jj) { float x;
                    if (st == 0) x = sa[0][jj] - c0;
                    else if (st == 1) x = -INFINITY;
                    else { const unsigned rel = (unsigned)(R1 - (16 * st + jj)); x = fmaf((float)(16 * st + jj), r8, sa[st][jj]); x = (rel <= hi) ? x : -INFINITY; }
                    sa[st][jj] = x; mx = fmaxf(mx, x); }
            mx = fmaxf(mx, __shfl_xor(mx, 16)); mx = fmaxf(mx, __shfl_xor(mx, 32));
            const float nm = -mx * sc2;
            float sum = 0.f;
#pragma unroll
            for (int st = 0; st < 18; ++st)
#pragma unroll
                for (int jj = 0; jj < 4; ++jj) { const float e = __builtin_amdgcn_exp2f(fmaf(sa[st][jj], sc2, nm)); sa[st][jj] = e; sum += e; }
            sum += __shfl_xor(sum, 16); sum += __shfl_xor(sum, 32); sum += __builtin_amdgcn_exp2f(fmaf(8.f * sink - c0, sc2, nm));
            const float inv = 1.f / sum;
            f32x4 oa[4];
#pragma unroll
            for (int dt = 0; dt < 4; ++dt) oa[dt] = (f32x4){0.f, 0.f, 0.f, 0.f};
#pragma unroll
            for (int u = 0; u < 9; ++u) { u32x4 pw; pw.x = pk2(sa[2 * u][0], sa[2 * u][1]); pw.y = pk2(sa[2 * u][2], sa[2 * u][3]); pw.z = pk2(sa[2 * u + 1][0], sa[2 * u + 1][1]); pw.w = pk2(sa[2 * u + 1][2], sa[2 * u + 1][3]);
                const bf16x8 pf = as_bf16x8(pw);
#pragma unroll
                for (int dt = 0; dt < 4; ++dt) { const LAS bf16_t* vr = Vt + (16 * dt + fr) * VP + 32 * u + 4 * fq; const u32x2 v0 = *(const LAS u32x2*)vr, v1 = *(const LAS u32x2*)(vr + 16);
                    u32x4 vw; vw.x = v0.x; vw.y = v0.y; vw.z = v1.x; vw.w = v1.y;
                    oa[dt] = __builtin_amdgcn_mfma_f32_16x16x32_bf16(as_bf16x8(vw), pf, oa[dt], 0, 0, 0); }
                if ((u & 3) == 3) __builtin_amdgcn_sched_barrier(0); }
#pragma unroll
            for (int dt = 0; dt < 4; ++dt) { const int col = 64 * H + 16 * dt + 4 * fq; const u32x2 zz = zc[dt];
                u32x2 w; w.x = pk2(oa[dt][0] * inv * silu(lo_f(zz.x)), oa[dt][1] * inv * silu(hi_f(zz.x))); w.y = pk2(oa[dt][2] * inv * silu(lo_f(zz.y)), oa[dt][3] * inv * silu(hi_f(zz.y)));
                if (!dry) *(u32x2*)(rowp + col) = w; }
        }
    }
}

__device__ __forceinline__ u32x4 xbc_row(const bf16_t* bufB, const bf16_t* mxbc, int b, int pos, int xc) {
    const int pm = pos < 0 ? 0 : pos;
    const bf16_t* ptr = (pos < 16) ? mxbc + pm * 3072 + xc : bufB + (size_t)(b * TSEQ + pos - 16) * LDB_S + 2048 + xc;
    return *(const u32x4*)ptr;
}
template <int NR> __device__ __forceinline__ void raw_load(const bf16_t* bufB, const bf16_t* mxbc, int b, int pos0, int xc, u32x4 (&rw)[NR + 3]) {
#pragma unroll
    for (int i = 0; i < NR + 3; ++i) rw[i] = xbc_row(bufB, mxbc, b, pos0 - 3 + i, xc);
}
template <int NR, int CS = 320> __device__ __forceinline__ void conv_block(const LAS float* cwl, const u32x4 (&rw)[NR + 3], int pos0, int lc, float (&out)[NR][8]) {
    { const f32x4 a = *(const LAS f32x4*)(cwl + 4 * CS + lc), c = *(const LAS f32x4*)(cwl + 4 * CS + lc + 4);
#pragma unroll
      for (int r = 0; r < NR; ++r) { out[r][0] = a[0]; out[r][1] = a[1]; out[r][2] = a[2]; out[r][3] = a[3]; out[r][4] = c[0]; out[r][5] = c[1]; out[r][6] = c[2]; out[r][7] = c[3]; } }
#pragma unroll
    for (int k = 0; k < 4; ++k) { const f32x4 wa = *(const LAS f32x4*)(cwl + k * CS + lc), wb = *(const LAS f32x4*)(cwl + k * CS + lc + 4);
#pragma unroll
        for (int r = 0; r < NR; ++r) { u32x4 r_ = rw[r + k]; if (pos0 - 3 + r + k < 0) r_ = (u32x4){0u, 0u, 0u, 0u};
            out[r][0] += wa[0] * lo_f(r_.x); out[r][1] += wa[1] * hi_f(r_.x); out[r][2] += wa[2] * lo_f(r_.y); out[r][3] += wa[3] * hi_f(r_.y);
            out[r][4] += wb[0] * lo_f(r_.z); out[r][5] += wb[1] * hi_f(r_.z); out[r][6] += wb[2] * lo_f(r_.w); out[r][7] += wb[3] * hi_f(r_.w); } }
#pragma unroll
    for (int r = 0; r < NR; ++r) { const float lf = (pos0 + r) >= 0 ? 1.f : 0.f;
#pragma unroll
        for (int ch = 0; ch < 8; ++ch) out[r][ch] = silu(out[r][ch]) * lf; }
}

__device__ __forceinline__ void convbc_phase(const Params& p, LAS unsigned char* lds) {
    const int tid = threadIdx.x, lane = tid & 63, w = __builtin_amdgcn_readfirstlane(tid >> 6), fr = lane & 15, fq = lane >> 4;
    constexpr int LP = 136;
    LAS bf16_t* Bs = (LAS bf16_t*)lds; LAS bf16_t* Cs = (LAS bf16_t*)(lds + 34816);
    LAS float* cw2 = (LAS float*)(lds + 69632);
    const bf16_t* bufB = (const bf16_t*)(p.ws + WS_BUF); const bf16_t* mxbc = (const bf16_t*)(p.ws + WS_MXBC);
    bf16_t* CB = (bf16_t*)(p.ws + WS_U); bf16_t* MCB = (bf16_t*)(p.ws + WS_MCB); float* MT = (float*)((char*)p.out + (size_t)NROW * DM * 2);
    __syncthreads();
    for (int i = tid; i < 5 * 1024; i += 512) { const int k = i >> 10, ch = i & 1023; cw2[i] = (k < 4) ? p.conv_w[k * 3072 + 2048 + ch] : p.conv_b[2048 + ch]; }
    __syncthreads();
    for (int it = blockIdx.x; it < 512; it += gridDim.x) {
        const int b = it & 7, g = (it >> 3) & 3, ci = it >> 5;
        const int r4 = tid >> 4, oc = tid & 15, pos0 = 16 + 128 * ci + 4 * r4, colB = 128 * g + 8 * oc, colC = 512 + colB;
        u32x4 rb[7], rc[7];
        raw_load<4>(bufB, mxbc, b, pos0, 2048 + colB, rb); raw_load<4>(bufB, mxbc, b, pos0, 2048 + colC, rc);
        bf16_t* dst = CB + (size_t)(b * TSEQ + pos0 - 16) * 1024;
        { float o[4][8]; conv_block<4, 1024>(cw2, rb, pos0, colB, o);
#pragma unroll
          for (int r = 0; r < 4; ++r) { u32x4 v; v.x = pk2(o[r][0], o[r][1]); v.y = pk2(o[r][2], o[r][3]); v.z = pk2(o[r][4], o[r][5]); v.w = pk2(o[r][6], o[r][7]);
              *(u32x4*)(dst + r * 1024 + colB) = v; *(LAS u32x4*)(Bs + (4 * r4 + r) * LP + 8 * oc) = v; } }
        { float o[4][8]; conv_block<4, 1024>(cw2, rc, pos0, colC, o);
#pragma unroll
          for (int r = 0; r < 4; ++r) { u32x4 v; v.x = pk2(o[r][0], o[r][1]); v.y = pk2(o[r][2], o[r][3]); v.z = pk2(o[r][4], o[r][5]); v.w = pk2(o[r][6], o[r][7]);
              *(u32x4*)(dst + r * 1024 + colC) = v; *(LAS u32x4*)(Cs + (4 * r4 + r) * LP + 8 * oc) = v; } }
        __syncthreads();
        { bf16x8 cf[4];
#pragma unroll
          for (int kn = 0; kn < 4; ++kn) cf[kn] = *(const LAS bf16x8*)(Cs + (16 * w + fr) * LP + 32 * kn + 8 * fq);
          float* mo = MT + ((size_t)(it * 8 + w) * 8) * 256 + lane * 4;
#pragma unroll
          for (int st = 0; st < 8; ++st) if (st <= w) { f32x4 m = {0.f, 0.f, 0.f, 0.f};
#pragma unroll
              for (int kn = 0; kn < 4; ++kn) { const bf16x8 a = *(const LAS bf16x8*)(Bs + (16 * st + fr) * LP + 32 * kn + 8 * fq); m = __builtin_amdgcn_mfma_f32_16x16x32_bf16(a, cf[kn], m, 0, 0, 0); }
              *(f32x4*)(mo + st * 256) = m; } }
        __syncthreads();
    }
    if (blockIdx.x == gridDim.x - 1) {
        const int oc = tid & 127, pos0 = 4 * (tid >> 7); u32x4 rw[7]; float o[4][8];
        raw_load<4>(bufB, mxbc, 0, pos0, 2048 + 8 * oc, rw);
        conv_block<4, 1024>(cw2, rw, pos0, 8 * oc, o);
#pragma unroll
        for (int r = 0; r < 4; ++r) { u32x4 v; v.x = pk2(o[r][0], o[r][1]); v.y = pk2(o[r][2], o[r][3]); v.z = pk2(o[r][4], o[r][5]); v.w = pk2(o[r][6], o[r][7]); *(u32x4*)(MCB + (pos0 + r) * 1024 + 8 * oc) = v; }
    }
}
__device__ __forceinline__ u32x4 cb_row(const bf16_t* CB, const bf16_t* MCB, int b, int pos, int col) {
    const int pm = pos < 0 ? 0 : pos;
    const bf16_t* ptr = (pos < 16) ? MCB + pm * 1024 + col : CB + (size_t)(b * TSEQ + pos - 16) * 1024 + col;
    return *(const u32x4*)ptr;
}
__device__ __forceinline__ void cb_load4(const bf16_t* CB, const bf16_t* MCB, int b, int pos0, int col, u32x4 (&rw)[4]) {
#pragma unroll
    for (int i = 0; i < 4; ++i) rw[i] = cb_row(CB, MCB, b, pos0 + i, col);
}

#define SSD_LBAR() do { asm volatile("s_waitcnt lgkmcnt(0)" ::: "memory"); __builtin_amdgcn_s_barrier(); asm volatile("" ::: "memory"); } while (0)
__device__ __forceinline__ void ssd_phase(const Params& p, LAS unsigned char* lds, bool dry = false) {
    const int tid = threadIdx.x, lane0 = tid & 63, w = __builtin_amdgcn_readfirstlane(tid >> 6);
    constexpr int LP = 136;
    LAS bf16_t* Bs  = (LAS bf16_t*)lds;
    LAS bf16_t* Cs  = (LAS bf16_t*)(lds + 34816);
    LAS bf16_t* BsT = (LAS bf16_t*)(lds + 69632);
    LAS bf16_t* Xt  = (LAS bf16_t*)(lds + 104448);
    LAS bf16_t* Sl  = (LAS bf16_t*)(lds + 121856);
    LAS float* acs = (LAS float*)(lds + 139264); LAS float* dts = acs + 128; LAS float* wl = acs + 256;
    LAS float* cwl = (LAS float*)(lds + 140800);
    bf16_t* bufB = (bf16_t*)(p.ws + WS_BUF); const bf16_t* mxbc = (const bf16_t*)(p.ws + WS_MXBC);
    const bf16_t* CB = (const bf16_t*)(p.ws + WS_U); const bf16_t* MCB = (const bf16_t*)(p.ws + WS_MCB); const float* MT = (const float*)((const char*)p.out + (size_t)NROW * DM * 2);
    const float* dtb = (const float*)(p.ws + WS_DT); const float* mdt = (const float*)(p.ws + WS_MDT); float* ssq = (float*)(p.ws + WS_SSQ);
    const bool lowhalf = w < 4;
    for (int item = blockIdx.x; item < 256; item += gridDim.x) {
        const int b = item & 7, h = item >> 3, g = h >> 3;
        const float A_h = -__expf(p.a_log[h]), D_h = p.d_skip[h];
        f32x4 accS[4];
#pragma unroll
        for (int pt = 0; pt < 4; ++pt) accS[pt] = (f32x4){0.f, 0.f, 0.f, 0.f};
        __syncthreads();
        for (int i = tid; i < 64 * LP / 2; i += 512) ((LAS unsigned*)Sl)[i] = 0u;
        for (int i = tid; i < 5 * 320; i += 512) { const int k = i / 320, lc = i - 320 * k; const int xc = lc < 128 ? 2048 + 128 * g + lc : (lc < 256 ? 2560 + 128 * g + (lc - 128) : 64 * h + (lc - 256));
            cwl[i] = (k < 4) ? p.conv_w[k * 3072 + xc] : p.conv_b[xc]; }
        u32x4 rwA0[4], rwA1[4], rwX[5]; float dn0 = 0.f, dn1 = 0.f;
        if (w == 0) dn1 = (lane0 >= 48) ? mdt[(lane0 - 48) * 32 + h] : 0.f;
#pragma unroll 1
        for (int c = 0; c < 17; ++c) {
            const int pos_base = (c == 0) ? -112 : 16 + 128 * (c - 1);
            int lane = lane0; asm volatile("" : "+v"(lane));
            const int fr = lane & 15, fq = lane >> 4, t2 = lane + 64 * (w & 3);
            const int colA = (lowhalf ? 0 : 512) + 128 * g + 8 * (t2 & 15), r4A = 2 * (t2 >> 4);
            const int tX = lane + 64 * w, xcX = 64 * h + 8 * (tX & 7), r2X = tX >> 3;
            if (c == 0) {
                if (lowhalf) { cb_load4(CB, MCB, b, pos_base + 4 * r4A, colA, rwA0); cb_load4(CB, MCB, b, pos_base + 4 * r4A + 4, colA, rwA1); }
                raw_load<2>(bufB, mxbc, b, pos_base + 2 * r2X, xcX, rwX); }
            f32x4 mt[8];
            if (c > 0) { const float* mp = MT + ((size_t)((b + 8 * (g + 4 * (c - 1))) * 8 + w) * 8) * 256 + lane * 4;
#pragma unroll
                for (int st = 0; st < 8; ++st) if (st <= w) mt[st] = *(const f32x4*)(mp + st * 256); }
            if (w == 0) { const float d0 = dn0, d1 = dn1;
                float a0 = d0 * A_h, a1 = d1 * A_h;
                a0 = wave_scan(a0); a1 = wave_scan(a1);
                a1 += __builtin_bit_cast(float, __builtin_amdgcn_readlane(__builtin_bit_cast(int, a0), 63)); const float alast = __builtin_bit_cast(float, __builtin_amdgcn_readlane(__builtin_bit_cast(int, a1), 63));
                acs[lane] = a0; acs[lane + 64] = a1; dts[lane] = d0; dts[lane + 64] = d1;
                wl[lane] = d0 * __expf(alast - a0); wl[lane + 64] = d1 * __expf(alast - a1); }
            SSD_LBAR();
#ifdef SSD_DRY_SKIPB
            if (!dry)
#endif
            { if (lowhalf) {
#pragma unroll
                  for (int hf = 0; hf < 2; ++hf) { const int r4 = r4A + hf, oc = t2 & 15; float o[4][8];
#pragma unroll
                      for (int r = 0; r < 4; ++r) { u32x4 v = hf == 0 ? rwA0[r] : rwA1[r]; if (pos_base + 4 * r4 + r < 0) v = (u32x4){0u, 0u, 0u, 0u};
                          o[r][0] = lo_f(v.x); o[r][1] = hi_f(v.x); o[r][2] = lo_f(v.y); o[r][3] = hi_f(v.y); o[r][4] = lo_f(v.z); o[r][5] = hi_f(v.z); o[r][6] = lo_f(v.w); o[r][7] = hi_f(v.w); }
                      const f32x4 ww = *(const LAS f32x4*)(wl + 4 * r4);
#pragma unroll
                      for (int ch = 0; ch < 8; ++ch) { u32x2 v; v.x = pk2(o[0][ch] * ww[0], o[1][ch] * ww[1]); v.y = pk2(o[2][ch] * ww[2], o[3][ch] * ww[3]); *(LAS u32x2*)(BsT + (8 * oc + ch) * LP + 8 * ((r4 >> 1) ^ oc) + 4 * (r4 & 1)) = v; } } }
              else if (c > 0) {
#pragma unroll
                  for (int hf = 0; hf < 2; ++hf) { const int r4 = r4A + hf, oc = t2 & 15;
#pragma unroll
                      for (int r = 0; r < 4; ++r) *(LAS u32x4*)(Cs + (4 * r4 + r) * LP + 8 * oc) = hf == 0 ? rwA0[r] : rwA1[r]; } }
            }
            { float o2[2][8]; conv_block<2>(cwl, rwX, pos_base + 2 * r2X, 256 + 8 * (tX & 7), o2); const int oc = tX & 7;
#pragma unroll
              for (int ch = 0; ch < 8; ++ch) *(LAS unsigned*)(Xt + (8 * oc + ch) * LP + 8 * ((r2X >> 2) ^ oc) + 2 * (r2X & 3)) = pk2(o2[0][ch], o2[1][ch]); }
            SSD_LBAR();
            const int l = 16 * w + fr;
            bf16_t* zp = bufB + (size_t)(b * TSEQ + 128 * (c > 0 ? c - 1 : 0) + l) * LDB_S + 64 * h;
            if (c < 16 && w == 0) { const size_t rb = (size_t)(b * TSEQ + 128 * c); dn0 = dtb[(rb + lane) * 32 + h]; dn1 = dtb[(rb + lane + 64) * 32 + h]; }
            if (c < 16) { const int pb = 16 + 128 * c;
                cb_load4(CB, MCB, b, pb + 4 * r4A, colA, rwA0); cb_load4(CB, MCB, b, pb + 4 * r4A + 4, colA, rwA1);
                raw_load<2>(bufB, mxbc, b, pb + 2 * r2X, xcX, rwX); }
            __builtin_amdgcn_sched_barrier(0);
            u32x2 zz[4];
#pragma unroll
            for (int pt = 0; pt < 4; ++pt) zz[pt] = *(const u32x2*)(zp + 16 * pt + 4 * fq);
            { const float elast = __expf(acs[127]);
#pragma unroll
              for (int pt = 0; pt < 4; ++pt) accS[pt] = accS[pt] * elast;
#pragma unroll
              for (int ul = 0; ul < 4; ++ul) { const bf16x8 bfr = *(const LAS bf16x8*)(BsT + (16 * w + fr) * LP + 8 * ((4 * ul + fq) ^ ((2 * w + (fr >> 3)) & 15)));
#pragma unroll
                  for (int pt = 0; pt < 4; ++pt) { const bf16x8 a = *(const LAS bf16x8*)(Xt + (16 * pt + fr) * LP + 8 * ((4 * ul + fq) ^ ((2 * pt + (fr >> 3)) & 7))); accS[pt] = __builtin_amdgcn_mfma_f32_16x16x32_bf16(a, bfr, accS[pt], 0, 0, 0); } } }
            __builtin_amdgcn_sched_barrier(0);
            f32x4 yv[4];
#ifdef SSD_DRY_SKIP
            const bool doC = (c > 0) && !dry;
#else
            const bool doC = (c > 0);
#endif
            if (doC) {
                bf16x8 cf[4];
#pragma unroll
                for (int kn = 0; kn < 4; ++kn) cf[kn] = *(const LAS bf16x8*)(Cs + (16 * w + fr) * LP + 32 * kn + 8 * fq);
                f32x4 accO[4], accY[4];
#pragma unroll
                for (int pt = 0; pt < 4; ++pt) { accO[pt] = (f32x4){0.f, 0.f, 0.f, 0.f}; accY[pt] = (f32x4){0.f, 0.f, 0.f, 0.f};
#pragma unroll
                    for (int kn = 0; kn < 4; ++kn) { const bf16x8 a = *(const LAS bf16x8*)(Sl + (16 * pt + fr) * LP + 32 * kn + 8 * fq); accO[pt] = __builtin_amdgcn_mfma_f32_16x16x32_bf16(a, cf[kn], accO[pt], 0, 0, 0); } }
                const float acl = acs[l], el = __expf(acl);
#pragma unroll
                for (int pt = 0; pt < 4; ++pt) accY[pt] = accO[pt] * el;
                __builtin_amdgcn_sched_barrier(0);
#pragma unroll
                for (int u = 0; u < 4; ++u) if (2 * u <= w) {
                    f32x4 m0 = mt[2 * u], m1 = {0.f, 0.f, 0.f, 0.f};
                    if (2 * u + 1 <= w) m1 = mt[2 * u + 1];
                    float v0[4], v1[4];
                    const f32x4 as0 = *(const LAS f32x4*)(acs + 32 * u + 4 * fq), as1 = *(const LAS f32x4*)(acs + 32 * u + 16 + 4 * fq);
                    const f32x4 ds0 = *(const LAS f32x4*)(dts + 32 * u + 4 * fq), ds1 = *(const LAS f32x4*)(dts + 32 * u + 16 + 4 * fq);
#pragma unroll
                    for (int jj = 0; jj < 4; ++jj) { const int s0 = 32 * u + 4 * fq + jj, s1 = s0 + 16;
                        const float e0 = __expf(fminf(acl - as0[jj], 0.f)) * ds0[jj], e1 = __expf(fminf(acl - as1[jj], 0.f)) * ds1[jj];
                        const float t0 = m0[jj] * e0, t1 = m1[jj] * e1;
                        v0[jj] = ((s0 <= l) ? t0 : 0.f) + ((s0 == l) ? D_h : 0.f); v1[jj] = ((s1 <= l) ? t1 : 0.f) + ((s1 == l) ? D_h : 0.f); }
                    u32x4 pw; pw.x = pk2(v0[0], v0[1]); pw.y = pk2(v0[2], v0[3]); pw.z = pk2(v1[0], v1[1]); pw.w = pk2(v1[2], v1[3]);
                    const bf16x8 pf = as_bf16x8(pw);
#pragma unroll
                    for (int pt = 0; pt < 4; ++pt) { const int gx = (2 * pt + (fr >> 3)) & 7, jx = 4 * u + (fq >> 1); const LAS bf16_t* xrow = Xt + (16 * pt + fr) * LP + 4 * (fq & 1); const u32x2 x0 = *(const LAS u32x2*)(xrow + 8 * (jx ^ gx)), x1 = *(const LAS u32x2*)(xrow + 8 * ((jx + 2) ^ gx));
                        u32x4 xw; xw.x = x0.x; xw.y = x0.y; xw.z = x1.x; xw.w = x1.y;
                        accY[pt] = __builtin_amdgcn_mfma_f32_16x16x32_bf16(as_bf16x8(xw), pf, accY[pt], 0, 0, 0); } }
#pragma unroll
                for (int pt = 0; pt < 4; ++pt) yv[pt] = accY[pt];
            }
            SSD_LBAR();
#pragma unroll
            for (int pt = 0; pt < 4; ++pt)
#pragma unroll
                for (int jj = 0; jj < 4; ++jj) Sl[(16 * pt + 4 * fq + jj) * LP + 16 * w + fr] = (bf16_t)(pk2(accS[pt][jj], 0.f) & 0xffffu);
            if (doC) { const size_t row = (size_t)(b * TSEQ + 128 * (c - 1) + l); float ss = 0.f;
#pragma unroll
                for (int pt = 0; pt < 4; ++pt) { const u32x2 z_ = zz[pt];
                    const float y0 = yv[pt][0] * silu(lo_f(z_.x)), y1 = yv[pt][1] * silu(hi_f(z_.x)), y2 = yv[pt][2] * silu(lo_f(z_.y)), y3 = yv[pt][3] * silu(hi_f(z_.y));
                    ss += y0 * y0 + y1 * y1 + y2 * y2 + y3 * y3;
                    u32x2 o; o.x = pk2(y0, y1); o.y = pk2(y2, y3); if (!dry) *(u32x2*)(zp + 16 * pt + 4 * fq) = o; }
                ss += __shfl_xor(ss, 16); ss += __shfl_xor(ss, 32);
                if (fq == 0) ssq[row * 32 + h] = ss; }
        }
    }
}

__device__ __forceinline__ void gnorm_phase(const Params& p, bool dry = false) {
    bf16_t* bufB = (bf16_t*)(p.ws + WS_BUF); const float* ssq = (const float*)(p.ws + WS_SSQ);
    const int nthr = gridDim.x * 512;
    for (int v = blockIdx.x * 512 + threadIdx.x; v < NROW * 256; v += nthr) { const int row = v >> 8, rem = v & 255, g = rem >> 6, oc = rem & 63;
        const f32x4 s0 = *(const f32x4*)(ssq + (size_t)row * 32 + 8 * g), s1 = *(const f32x4*)(ssq + (size_t)row * 32 + 8 * g + 4);
        const float rstd = rsqrtf(((s0[0] + s0[1]) + (s0[2] + s0[3]) + (s1[0] + s1[1]) + (s1[2] + s1[3])) * (1.f / 512.f) + EPS);
        bf16_t* ptr = bufB + (size_t)row * LDB_S + 512 * g + 8 * oc; const u32x4 a = *(const u32x4*)ptr; u32x4 o;
        o.x = pk2(lo_f(a.x) * rstd, hi_f(a.x) * rstd); o.y = pk2(lo_f(a.y) * rstd, hi_f(a.y) * rstd); o.z = pk2(lo_f(a.z) * rstd, hi_f(a.z) * rstd); o.w = pk2(lo_f(a.w) * rstd, hi_f(a.w) * rstd);
        if (!dry) *(u32x4*)ptr = o; }
}
__device__ __forceinline__ void final_phase(const Params& p) {
    const int lane = threadIdx.x & 63, wave = threadIdx.x >> 6, G = gridDim.x; const bf16_t* of = (const bf16_t*)(p.ws + WS_BUF);
    f32x4 gg[4];
#pragma unroll
    for (int i = 0; i < 4; ++i) gg[i] = *(const f32x4*)(p.g_post + 4 * lane + 256 * i);
    for (int row0 = blockIdx.x * 8 + wave; row0 < NROW; row0 += G * 32) { u32x2 rv[4][4]; f32x4 xx[4][4];
#pragma unroll
        for (int r = 0; r < 4; ++r) { const int row = row0 + r * G * 8; const int rr = row < NROW ? row : row0;
#pragma unroll
            for (int i = 0; i < 4; ++i) { rv[r][i] = *(const u32x2*)(of + (size_t)rr * DM + 4 * lane + 256 * i); xx[r][i] = *(const f32x4*)(p.x + (size_t)rr * DM + 4 * lane + 256 * i); } }
#pragma unroll
        for (int r = 0; r < 4; ++r) { const int row = row0 + r * G * 8; f32x4 v[4]; float s = 0.f;
#pragma unroll
            for (int i = 0; i < 4; ++i) { v[i] = (f32x4){lo_f(rv[r][i].x), hi_f(rv[r][i].x), lo_f(rv[r][i].y), hi_f(rv[r][i].y)}; s += v[i][0] * v[i][0] + v[i][1] * v[i][1] + v[i][2] * v[i][2] + v[i][3] * v[i][3]; }
            const float rstd = rsqrtf(wave_sum(s) * (1.f / DM) + EPS);
            if (row < NROW) {
#pragma unroll
                for (int i = 0; i < 4; ++i) *(f32x4*)(p.out + (size_t)row * DM + 4 * lane + 256 * i) = xx[r][i] + v[i] * rstd * gg[i]; } } }
}

__global__ void __launch_bounds__(512, 2) fwd_kernel(Params p) {
    extern __shared__ __attribute__((aligned(16))) unsigned char smem[];
    LAS unsigned char* lds = (LAS unsigned char*)smem;
    cg::grid_group grid = cg::this_grid();
    volatile LAS unsigned* bst = (volatile LAS unsigned*)(lds + LDS_BYTES - 16);
    if (threadIdx.x < 4) bst[threadIdx.x] = 0u;
    __syncthreads();
    const XcdBarrier xbar = xcd_barrier_post((unsigned*)(p.ws + WS_BAR), bst);
    if (p.ph_lo == 0x7fffffff) grid.sync();
#define GSYNC() xcd_barrier(xbar)
    unsigned char* ws = p.ws; const int G = gridDim.x, lo = p.ph_lo, hi = p.ph_hi;
    bf16_t* buf = (bf16_t*)(ws + WS_BUF); bf16_t* U = (bf16_t*)(ws + WS_U); bf16_t* m1 = (bf16_t*)p.out;
#ifndef REP0
#define REP0 1
#endif
#ifndef REP1
#define REP1 1
#endif
#ifndef REP2
#define REP2 1
#endif
#ifndef REP3
#define REP3 1
#endif
#ifndef REP4
#define REP4 1
#endif
#ifndef REP5
#define REP5 1
#endif
#ifndef REP6
#define REP6 1
#endif
#ifndef REP7
#define REP7 1
#endif
#ifndef REP8
#define REP8 1
#endif
#ifndef REP9
#define REP9 1
#endif
#ifndef GEMM_SP2
#define GEMM_SP2 true
#endif
#ifndef GEMM_ALIGN
#define GEMM_ALIGN true
#endif
#ifndef PHASE_MASK
#define PHASE_MASK 0x3ff
#endif
#define IN(k) ((((PHASE_MASK) >> (k)) & 1) && lo <= (k) && (k) < hi)
#define SEAM(k) do { if (IN(k) && IN((k) + 1)) { GSYNC(); } } while (0)
#define DRY (REP0 > 1 && rep_ + lo < REP0 - 1)
    if (IN(0)) for (int rep_ = 0; rep_ < REP0; ++rep_) { if (rep_) { GSYNC(); } prep_phase(p, lds); }
#undef DRY
    SEAM(0);
#define DRY (REP1 > 1 && rep_ + lo < REP1 - 1)
    if (IN(1)) for (int rep_ = 0; rep_ < REP1; ++rep_) { if (rep_) { GSYNC(); } { pg8::Gemm g{U, (const bf16_t*)(ws + WS_WT_ATT), NROW, NATT, DM, DM, DM}; pg8::StaticOrder S; S.init(NROW, NATT, G, (int)blockIdx.x);
        EpiAtt E{buf, (float*)(ws + WS_DT), p.dt_bias}; pg8::gemm_phase2<EpiAtt, pg8::StaticOrder, GEMM_ALIGN, GEMM_SP2>(lds, g, S, E); } }
#undef DRY
    SEAM(1);
#define DRY (REP2 > 1 && rep_ + lo < REP2 - 1)
    if (IN(2)) for (int rep_ = 0; rep_ < REP2; ++rep_) { if (rep_) { GSYNC(); } attn_phase(p, lds, DRY); }
#undef DRY
    SEAM(2);
#define DRY (REP3 > 1 && rep_ + lo < REP3 - 1)
    if (IN(3)) for (int rep_ = 0; rep_ < REP3; ++rep_) { if (rep_) { GSYNC(); } { pg8::Gemm g{buf, (const bf16_t*)(ws + WS_WOA), NROW, DM, DM, LDA_A, DM}; pg8::StaticOrder S; S.init(NROW, DM, G, (int)blockIdx.x);
        EpiYatt E{buf, m1}; pg8::gemm_phase2<EpiYatt, pg8::StaticOrder, false, GEMM_SP2>(lds, g, S, E); } }
#undef DRY
    SEAM(3);
#define DRY (REP4 > 1 && rep_ + lo < REP4 - 1)
    if (IN(4)) for (int rep_ = 0; rep_ < REP4; ++rep_) { if (rep_) { GSYNC(); } { pg8::Gemm g{U, (const bf16_t*)(ws + WS_WT_SSM), NROW, LDB_S, DM, DM, DM}; pg8::StaticOrder S; S.init(NROW, LDB_S, G, (int)blockIdx.x);
        EpiStore E{buf, LDB_S}; pg8::gemm_phase2<EpiStore, pg8::StaticOrder, GEMM_ALIGN, GEMM_SP2>(lds, g, S, E); } }
#undef DRY
    SEAM(4);
#define DRY (REP5 > 1 && rep_ + lo < REP5 - 1)
    if (IN(5)) for (int rep_ = 0; rep_ < REP5; ++rep_) { if (rep_) { GSYNC(); } convbc_phase(p, lds); GSYNC(); ssd_phase(p, lds, DRY); }
#undef DRY
    SEAM(5);
    const bool fuse_gn = (G == 256);
    if (IN(6) && !fuse_gn) gnorm_phase(p);
    if (IN(6) && IN(7) && !fuse_gn) { GSYNC(); }
    if (IN(7)) { pg8::Gemm g{buf, (const bf16_t*)(ws + WS_WOS), NROW, DM, 2048, LDB_S, 2048}; pg8::StaticOrder S; S.init(NROW, DM, G, (int)blockIdx.x);
        EpiYssm E{buf, m1, U};
        if (fuse_gn) { LAS float* gtab = (LAS float*)(lds + pg8::STAGE_BYTES);
            pg8::Unit u0; const bool has = S.next(0, u0);
            if (has && threadIdx.x < 256) { const float* sq = (const float*)(ws + WS_SSQ) + (size_t)(u0.pm * 256 + threadIdx.x) * 32; float rs[4];
#pragma unroll
                for (int gg = 0; gg < 4; ++gg) { const f32x4 s0 = *(const f32x4*)(sq + 8 * gg), s1 = *(const f32x4*)(sq + 8 * gg + 4);
                    rs[gg] = rsqrtf(((s0[0] + s0[1]) + (s0[2] + s0[3]) + (s1[0] + s1[1]) + (s1[2] + s1[3])) * (1.f / 512.f) + EPS); }
                gtab[threadIdx.x] = rs[0] / rs[1]; gtab[256 + threadIdx.x] = rs[1] / rs[2]; gtab[512 + threadIdx.x] = rs[2] / rs[3]; gtab[768 + threadIdx.x] = rs[3]; }
            __syncthreads();
            pg8::gemm_phase2<EpiYssm, pg8::StaticOrder, false, GEMM_SP2, true>(lds, g, S, E, gtab); }
        else pg8::gemm_phase2<EpiYssm, pg8::StaticOrder, false, GEMM_SP2>(lds, g, S, E); }
    SEAM(7);
#define DRY (REP8 > 1 && rep_ + lo < REP8 - 1)
    if (IN(8)) for (int rep_ = 0; rep_ < REP8; ++rep_) { if (rep_) { GSYNC(); } { pg8::Gemm g{U, (const bf16_t*)(ws + WS_WO), NROW, DM, DM, DM, DM}; pg8::StaticOrder S; S.init(NROW, DM, G, (int)blockIdx.x);
        EpiStore E{buf, DM}; pg8::gemm_phase2<EpiStore, pg8::StaticOrder, false, GEMM_SP2>(lds, g, S, E); } }
#undef DRY
    SEAM(8);
#define DRY (REP9 > 1 && rep_ + lo < REP9 - 1)
    if (IN(9)) for (int rep_ = 0; rep_ < REP9; ++rep_) { if (rep_) { GSYNC(); } final_phase(p); }
#undef DRY

#ifdef EXTRA_SYNCS
    for (int e_ = 0; e_ < EXTRA_SYNCS; ++e_) { GSYNC(); }
#endif
#ifdef DBG_STOP
    { GSYNC();
      const float* dtb = (const float*)(ws + WS_DT); const float* ssq = (const float*)(ws + WS_SSQ);
      const bf16_t* wa = (const bf16_t*)(ws + WS_WT_ATT); const bf16_t* wsm = (const bf16_t*)(ws + WS_WT_SSM); const bf16_t* woa = (const bf16_t*)(ws + WS_WOA); const bf16_t* wos = (const bf16_t*)(ws + WS_WOS); const bf16_t* wo = (const bf16_t*)(ws + WS_WO);
      const bf16_t* mkv = (const bf16_t*)(ws + WS_MKV); const bf16_t* mxbc = (const bf16_t*)(ws + WS_MXBC); const float* mdt = (const float*)(ws + WS_MDT);
      for (size_t i = (size_t)blockIdx.x * 512 + threadIdx.x; i < (size_t)NROW * DM; i += (size_t)G * 512) { const size_t r = i >> 10; const int c = (int)(i & 1023); float v = 0.f;
#define BF(ptr, idx) __uint_as_float(((unsigned)(ptr)[idx]) << 16)
          if (DBG_KIND == 0) v = BF(U, i) + BF(wa, (r % 3840) * 1024 + c) + BF(wsm, (r % 6144) * 1024 + c) + BF(woa, (r & 1023) * 1024 + c) + BF(wos, (r & 1023) * 2048 + c) + BF(wos, (r & 1023) * 2048 + 1024 + c) + BF(wo, (r & 1023) * 1024 + c)
                               + BF(mkv, (r & 15) * 512 + (c & 511)) + BF(mxbc, (r & 15) * 3072 + c + 1024 * ((r >> 4) % 3)) + mdt[(r & 15) * 32 + (c & 31)];
          if (DBG_KIND == 1) v = BF(buf, r * LDA_A + c) + BF(buf, r * LDA_A + 1024 + c) + BF(buf, r * LDA_A + 2048 + c) + BF(buf, r * LDA_A + 3072 + (c & 511)) + dtb[r * 32 + (c & 31)];
          if (DBG_KIND == 2) v = BF(buf, r * LDB_S + c) + BF(buf, r * LDB_S + 1024 + c) + BF(buf, r * LDB_S + 2048 + c) + BF(buf, r * LDB_S + 3072 + c) + BF(buf, r * LDB_S + 4096 + c) + BF(buf, r * LDB_S + 5120 + c) + ssq[r * 32 + (c & 31)];
          if (DBG_KIND == 5) v = BF(buf, r * LDB_S + c) + BF(buf, r * LDB_S + 1024 + c) + BF(buf, r * LDB_S + 2048 + c) + BF(buf, r * LDB_S + 3072 + c) + BF(buf, r * LDB_S + 4096 + c) + BF(buf, r * LDB_S + 5120 + c);
          if (DBG_KIND == 3) v = BF(U, i);
          if (DBG_KIND == 4) v = BF(buf, i);
          p.out[i] = v; }
    }
#endif
}
}

extern "C" void kernel_launch(void* const* d_in, const int* in_sizes, int n_in, void* d_out, int out_size, void* d_ws, size_t ws_size, hipStream_t stream) {
    using namespace mk;
    static int grid = 0;
    if (grid == 0) {
        if (n_in != 15 || out_size != NROW * DM || ws_size < WS_END) { fprintf(stderr, "kernel_launch: unexpected shapes (n_in %d out %d ws %zu need %zu)\n", n_in, out_size, ws_size, (size_t)WS_END); grid = -1; return; }
        int dev = 0, cus = 0, per_cu = 0;
        (void)hipGetDevice(&dev); (void)hipDeviceGetAttribute(&cus, hipDeviceAttributeMultiprocessorCount, dev);
        if (hipFuncSetAttribute((const void*)fwd_kernel, hipFuncAttributeMaxDynamicSharedMemorySize, LDS_BYTES) != hipSuccess) { fprintf(stderr, "kernel_launch: hipFuncSetAttribute failed\n"); grid = -1; return; }
        if (hipOccupancyMaxActiveBlocksPerMultiprocessor(&per_cu, (const void*)fwd_kernel, 512, LDS_BYTES) != hipSuccess || per_cu < 1) { fprintf(stderr, "kernel_launch: occupancy query gives %d\n", per_cu); (void)hipGetLastError(); grid = -1; return; }
        grid = cus;
    }
    if (grid < 0) return;
    if (hipMemsetAsync((char*)d_ws + WS_BAR, 0, 3456 * 4, stream) != hipSuccess) { fprintf(stderr, "kernel_launch: memset failed\n"); return; }
    Params p{};
    p.x = (const float*)d_in[0]; p.meta = (const float*)d_in[1]; p.g_pre = (const float*)d_in[2]; p.w_in = (const float*)d_in[3]; p.conv_w = (const float*)d_in[4]; p.conv_b = (const float*)d_in[5];
    p.dt_bias = (const float*)d_in[6]; p.a_log = (const float*)d_in[7]; p.d_skip = (const float*)d_in[8]; p.sinks = (const float*)d_in[9]; p.g_ssm = (const float*)d_in[10];
    p.w_oa = (const float*)d_in[11]; p.w_os = (const float*)d_in[12]; p.w_o = (const float*)d_in[13]; p.g_post = (const float*)d_in[14];
    p.out = (float*)d_out; p.ws = (unsigned char*)d_ws; p.ph_lo = 0; p.ph_hi = 10;
#ifdef DBG_STOP
    p.ph_hi = DBG_STOP + 1;
#endif
    void* args[] = {&p};
    hipError_t e = hipLaunchCooperativeKernel((const void*)fwd_kernel, dim3(grid), dim3(512), args, LDS_BYTES, stream);
    if (e != hipSuccess) fprintf(stderr, "kernel_launch: cooperative launch failed: %s (grid %d)\n", hipGetErrorString(e), grid);
}
```
